# Optimizing an MI355X kernel written in HIP

```python
import math, functools
import jax, jax.numpy as jnp
from jax import lax
import numpy as np

D_MODEL = 2048
BATCH = 1
SEQ = 8192
DEPTH = 2
DEC_BATCH = 8
DEC_SEQ = 64
PAST_LEN = 2048

CHUNK = 64
N_A_LAYERS = DEPTH // 2
N_B_LAYERS = DEPTH - N_A_LAYERS

GLA_HEADS = 4
GLA_DK = (D_MODEL // 2) // GLA_HEADS
GLA_DV = D_MODEL // GLA_HEADS
GLA_HK = GLA_HEADS * GLA_DK
GLA_HV = GLA_HEADS * GLA_DV
GLA_LOWRANK = 16
GLA_TAU = 16.0
GLA_IN = 2 * GLA_HK + 2 * GLA_HV + GLA_LOWRANK

FOX_HEADS = 16
FOX_HD = D_MODEL // FOX_HEADS
FOX_FORGET_BIAS = 3.0
Q_BLOCK = 128

D_FF = ((8 * D_MODEL // 3 + 255) // 256) * 256
EPS = 1e-6

kernel_name = 'streaming_gla_fox_yoco'


def rmsnorm(x, g):
    xf = x.astype(jnp.float32)
    y = xf * lax.rsqrt(jnp.mean(xf * xf, axis=-1, keepdims=True) + EPS)
    return (y * g.astype(jnp.float32)).astype(x.dtype)


def swiglu(u, w_in, w_out):
    gate, up = jnp.split(u @ w_in, 2, axis=-1)
    return (jax.nn.silu(gate) * up) @ w_out


def gla_scan(q, k, v, g, s0):
    B, L, H, DK = q.shape
    DV = v.shape[-1]
    C = CHUNK if L % CHUNK == 0 else L
    n = L // C

    def chunks(a):
        return a.astype(jnp.float32).reshape(B, n, C, H, a.shape[-1]).transpose(1, 0, 3, 2, 4)

    causal = jnp.tril(jnp.ones((C, C), dtype=bool))

    def step(S, inp):
        qc, kc, vc, gc = inp
        b = jnp.cumsum(gc, axis=2)
        o_inter = jnp.einsum('bhtd,bhdv->bhtv', qc * jnp.exp(b), S)
        diff = b[:, :, :, None, :] - b[:, :, None, :, :]
        decay = jnp.exp(jnp.where(causal[:, :, None], diff, -jnp.inf))
        att = jnp.einsum('bhtd,bhsd,bhtsd->bhts', qc, kc, decay)
        o_intra = jnp.einsum('bhts,bhsv->bhtv', att, vc)
        b_last = b[:, :, -1:, :]
        S_new = jnp.exp(b_last[:, :, 0, :])[..., None] * S + jnp.einsum(
            'bhsd,bhsv->bhdv', kc * jnp.exp(b_last - b), vc)
        return S_new, o_inter + o_intra

    S, o = lax.scan(step, s0.astype(jnp.float32), (chunks(q), chunks(k), chunks(v), chunks(g)))
    o = o.transpose(1, 0, 3, 2, 4).reshape(B, L, H, DV)
    return o, S


def gla_mixer(u, s0, w_in, w_gk2, b_gk, g_out, w_out):
    B, L, _ = u.shape
    proj = u @ w_in
    q, k, v, gate, gk_low = jnp.split(
        proj, [GLA_HK, 2 * GLA_HK, 2 * GLA_HK + GLA_HV, 2 * GLA_HK + 2 * GLA_HV], axis=-1)
    gk = jax.nn.log_sigmoid((gk_low @ w_gk2 + b_gk).astype(jnp.float32)) / GLA_TAU
    q = q.reshape(B, L, GLA_HEADS, GLA_DK) * (GLA_DK ** -0.5)
    k = k.reshape(B, L, GLA_HEADS, GLA_DK)
    v = v.reshape(B, L, GLA_HEADS, GLA_DV)
    gk = gk.reshape(B, L, GLA_HEADS, GLA_DK)
    o, S = gla_scan(q, k, v, gk, s0)
    gate = gate.reshape(B, L, GLA_HEADS, GLA_DV).astype(jnp.float32)
    o = rmsnorm(o, g_out) * jax.nn.silu(gate)
    return o.reshape(B, L, GLA_HV).astype(u.dtype) @ w_out, S


def shared_kv(h, kv_g, kv_w, kv_b_f, kv_g_k):
    B, L, _ = h.shape
    u = rmsnorm(h, kv_g)
    k, v, f = jnp.split(u @ kv_w, [D_MODEL, 2 * D_MODEL], axis=-1)
    k = rmsnorm(k.reshape(B, L, FOX_HEADS, FOX_HD), kv_g_k)
    v = v.reshape(B, L, FOX_HEADS, FOX_HD)
    logf = jax.nn.log_sigmoid((f + kv_b_f).astype(jnp.float32))
    return k, v, logf


def fox_block(qb, cqb, qi, k, v, ckT, k_idx):
    s = jnp.einsum('bqhd,bkhd->bhqk', qb.astype(jnp.float32), k.astype(jnp.float32)) * (FOX_HD ** -0.5)
    s = s + (cqb.transpose(0, 2, 1)[:, :, :, None] - ckT[:, :, None, :])
    s = jnp.where(k_idx[None, :] <= qi[:, None], s, -jnp.inf)
    p = jax.nn.softmax(s, axis=-1)
    return jnp.einsum('bhqk,bkhd->bqhd', p, v.astype(jnp.float32)).astype(v.dtype)


def fox_mixer(u, k_all, v_all, c_all, w_q, g_q, w_o):
    B, L, _ = u.shape
    Lk = k_all.shape[1]
    q = rmsnorm((u @ w_q).reshape(B, L, FOX_HEADS, FOX_HD), g_q)
    cq = c_all[:, Lk - L:]
    ckT = c_all.transpose(0, 2, 1)
    q_idx = jnp.arange(Lk - L, Lk)
    k_idx = jnp.arange(Lk)
    if L > Q_BLOCK and L % Q_BLOCK == 0:
        nb = L // Q_BLOCK
        qb = q.reshape(B, nb, Q_BLOCK, FOX_HEADS, FOX_HD).swapaxes(0, 1)
        cqb = cq.reshape(B, nb, Q_BLOCK, FOX_HEADS).swapaxes(0, 1)
        qib = q_idx.reshape(nb, Q_BLOCK)
        out = lax.map(lambda a: fox_block(a[0], a[1], a[2], k_all, v_all, ckT, k_idx), (qb, cqb, qib))
        out = out.swapaxes(0, 1).reshape(B, L, FOX_HEADS, FOX_HD)
    else:
        out = fox_block(q, cq, q_idx, k_all, v_all, ckT, k_idx)
    return out.reshape(B, L, D_MODEL) @ w_o


def trunk(x, gla_s0, past_k, past_v, past_logf, g_mix, g_ffn, gla_w_in, gla_w_gk2, gla_b_gk,
          gla_g_out, gla_w_out, kv_g, kv_w, kv_b_f, kv_g_k, fox_w_q, fox_g_q, fox_w_o,
          ffn_w_in, ffn_w_out):
    h = x
    gla_states = []
    k_new = v_new = logf_new = None
    k_all = v_all = c_all = None
    for i in range(DEPTH):
        u = rmsnorm(h, g_mix[i])
        if i < N_A_LAYERS:
            a, s = gla_mixer(u, gla_s0[i], gla_w_in[i], gla_w_gk2[i], gla_b_gk[i], gla_g_out[i], gla_w_out[i])
            gla_states.append(s)
        else:
            if i == N_A_LAYERS:
                k_new, v_new, logf_new = shared_kv(h, kv_g, kv_w, kv_b_f, kv_g_k)
                if past_k is None:
                    k_all, v_all, logf_all = k_new, v_new, logf_new
                else:
                    k_all = jnp.concatenate([past_k.astype(k_new.dtype), k_new], axis=1)
                    v_all = jnp.concatenate([past_v.astype(v_new.dtype), v_new], axis=1)
                    logf_all = jnp.concatenate([past_logf.astype(jnp.float32), logf_new], axis=1)
                c_all = jnp.cumsum(logf_all, axis=1)
            j = i - N_A_LAYERS
            a = fox_mixer(u, k_all, v_all, c_all, fox_w_q[j], fox_g_q[j], fox_w_o[j])
        h = h + a
        h = h + swiglu(rmsnorm(h, g_ffn[i]), ffn_w_in[i], ffn_w_out[i])
    return h, jnp.stack(gla_states).astype(x.dtype), k_new, v_new, logf_new.astype(x.dtype)


def setup_inputs(seed: int = 0) -> dict:
    key = jax.random.key(seed)
    ks = jax.random.split(key, 22)

    def nrm(k, shape, scale):
        return jax.random.normal(k, shape, jnp.float32) * scale

    return {
        'x_prompt': nrm(ks[0], (BATCH, SEQ, D_MODEL), 1.0),
        'x_sample': nrm(ks[1], (DEC_BATCH, DEC_SEQ, D_MODEL), 1.0),
        'state_gla': nrm(ks[2], (N_A_LAYERS, DEC_BATCH, GLA_HEADS, GLA_DK, GLA_DV), 0.1),
        'cache_k': nrm(ks[3], (DEC_BATCH, PAST_LEN, FOX_HEADS, FOX_HD), 1.0),
        'cache_v': nrm(ks[4], (DEC_BATCH, PAST_LEN, FOX_HEADS, FOX_HD), 1.0),
        'cache_logf': jax.nn.log_sigmoid(FOX_FORGET_BIAS + nrm(ks[5], (DEC_BATCH, PAST_LEN, FOX_HEADS), 1.0)),
        'g_mix': 1.0 + nrm(ks[6], (DEPTH, D_MODEL), 0.02),
        'g_ffn': 1.0 + nrm(ks[7], (DEPTH, D_MODEL), 0.02),
        'gla_w_in': nrm(ks[8], (N_A_LAYERS, D_MODEL, GLA_IN), D_MODEL ** -0.5),
        'gla_w_gk2': nrm(ks[9], (N_A_LAYERS, GLA_LOWRANK, GLA_HK), GLA_LOWRANK ** -0.5),
        'gla_b_gk': nrm(ks[10], (N_A_LAYERS, GLA_HK), 0.02),
        'gla_g_out': 1.0 + nrm(ks[11], (N_A_LAYERS, GLA_DV), 0.02),
        'gla_w_out': nrm(ks[12], (N_A_LAYERS, GLA_HV, D_MODEL), GLA_HV ** -0.5),
        'kv_g': 1.0 + nrm(ks[13], (D_MODEL,), 0.02),
        'kv_w': nrm(ks[14], (D_MODEL, 2 * D_MODEL + FOX_HEADS), D_MODEL ** -0.5),
        'kv_b_f': FOX_FORGET_BIAS + nrm(ks[15], (FOX_HEADS,), 0.1),
        'kv_g_k': 1.0 + nrm(ks[16], (FOX_HD,), 0.02),
        'fox_w_q': nrm(ks[17], (N_B_LAYERS, D_MODEL, D_MODEL), D_MODEL ** -0.5),
        'fox_g_q': 1.0 + nrm(ks[18], (N_B_LAYERS, FOX_HD), 0.02),
        'fox_w_o': nrm(ks[19], (N_B_LAYERS, D_MODEL, D_MODEL), D_MODEL ** -0.5),
        'ffn_w_in': nrm(ks[20], (DEPTH, D_MODEL, 2 * D_FF), D_MODEL ** -0.5),
        'ffn_w_out': nrm(ks[21], (DEPTH, D_FF, D_MODEL), D_FF ** -0.5),
    }


def reference(x_prompt, x_sample, state_gla, cache_k, cache_v, cache_logf, g_mix, g_ffn,
              gla_w_in, gla_w_gk2, gla_b_gk, gla_g_out, gla_w_out, kv_g, kv_w, kv_b_f, kv_g_k,
              fox_w_q, fox_g_q, fox_w_o, ffn_w_in, ffn_w_out):
    s0_prompt = jnp.zeros((N_A_LAYERS, x_prompt.shape[0], GLA_HEADS, GLA_DK, GLA_DV), x_prompt.dtype)
    y_prompt, sg_p, k_p, v_p, lf_p = trunk(
        x_prompt, s0_prompt, None, None, None, g_mix, g_ffn, gla_w_in, gla_w_gk2, gla_b_gk,
        gla_g_out, gla_w_out, kv_g, kv_w, kv_b_f, kv_g_k, fox_w_q, fox_g_q, fox_w_o, ffn_w_in, ffn_w_out)
    y_sample, sg_s, k_s, v_s, lf_s = trunk(
        x_sample, state_gla, cache_k, cache_v, cache_logf, g_mix, g_ffn, gla_w_in, gla_w_gk2, gla_b_gk,
        gla_g_out, gla_w_out, kv_g, kv_w, kv_b_f, kv_g_k, fox_w_q, fox_g_q, fox_w_o, ffn_w_in, ffn_w_out)
    return (y_prompt, y_sample, sg_p, k_p, v_p, lf_p, sg_s, k_s, v_s, lf_s)
```

```cpp
#include <hip/hip_runtime.h>
#include <hip/hip_cooperative_groups.h>
#include <cstdio>
namespace cg = cooperative_groups;
namespace pg8 {
#define PG8_LAS __attribute__((address_space(3)))
typedef unsigned short bf16_t;
typedef short bf16x8 __attribute__((ext_vector_type(8)));
typedef float f32x4 __attribute__((ext_vector_type(4)));
typedef unsigned u32x4 __attribute__((ext_vector_type(4)));
constexpr int BM = 256, BK = 64, HALF = 128, HTB = HALF * BK * 2  , STAGE_BYTES = 8 * HTB, NXCD = 8, WGM = 8;

__host__ __device__ __forceinline__ int lds_byte(int r, int c) { const int st = (r >> 4) * 2 + (c >> 5), rr = r & 15, cc = c & 31, ob = rr * 64 + cc * 2; return st * 1024 + (ob ^ (((ob >> 9) & 1) << 5)); }
__host__ __device__ __forceinline__ void stage_rc(int b, int& R, int& C) { const int st = b / 1024, sb = b % 1024, swz = sb ^ (((sb >> 9) & 1) << 5); R = (st >> 1) * 16 + swz / 64; C = (st & 1) * 32 + (swz % 64) / 2; }
__host__ __device__ __forceinline__ int perm32(int rho) { const int n = rho >> 4, i = rho & 15; return 8 * (i >> 2) + 4 * n + (i & 3); }

struct Unit { int pm, pn; };
struct Gemm { const bf16_t* A; const bf16_t* Bt; int M, N, K; };

struct StaticOrder {
    int nM, nN, nwg, G, c;
    __host__ __device__ void init(int M, int N, int G_, int c_) { nM = M / BM; nN = N / BM; nwg = nM * nN; G = G_; c = c_; }
    __host__ __device__ bool next(int i, Unit& u) const {
        const long L = (long)i * G + c; if (L >= nwg) return false;
        int wgid = (int)L; { const int q = nwg / NXCD, r = nwg % NXCD, xcd = wgid % NXCD, off = wgid / NXCD; wgid = (xcd < r ? xcd * (q + 1) : r * (q + 1) + (xcd - r) * q) + off; }
        const int nig = WGM * nN, gid = wgid / nig, fm = gid * WGM, gsz = (nM - fm) < WGM ? (nM - fm) : WGM;
        u.pm = fm + ((wgid % nig) % gsz); u.pn = (wgid % nig) / gsz; return true;
    }
    __device__ __forceinline__ void a_ready(const Unit&) const {}
    __device__ __forceinline__ void done(const Unit&) const {}
};
__device__ __forceinline__ unsigned cvt_pk_bf16(float lo, float hi) { unsigned r; asm volatile("v_cvt_pk_bf16_f32 %0, %1, %2" : "=v"(r) : "v"(lo), "v"(hi)); return r; }
template <class Epi, class Sched, bool STAMP = false>
__device__ __forceinline__ void gemm_phase(PG8_LAS unsigned char* lds, const Gemm g, const Sched& S, const Epi& E, unsigned long long* stamps) {
    int tid_ = threadIdx.x; asm volatile("" : "+v"(tid_)); const int tid = tid_, wid = __builtin_amdgcn_readfirstlane(tid >> 6), lane = tid & 63, wr = wid >> 2, wc = wid & 3, fr = lane & 15, fq = lane >> 4;
    const int K = g.K, nt = K / BK;
    int ts_lo = 0, ts_hi = 0, nts = 0; const unsigned long long rt_entry = STAMP ? (unsigned long long)wall_clock64() : 0ull;
#define PG8_STAMP() do { if (STAMP && wid == 0 && nts < 64) { const unsigned long long _c = (unsigned long long)clock64(); \
        ts_lo = (lane == nts) ? (int)(unsigned)_c : ts_lo; ts_hi = (lane == nts) ? (int)(unsigned)(_c >> 32) : ts_hi; ++nts; } } while (0)
    PG8_STAMP();
    unsigned voffA[2], voffB[2];
#pragma unroll
    for (int i = 0; i < 2; ++i) { int R, C; stage_rc(tid * 16 + i * 8192, R, C); const int Rb = Epi::PERM ? ((R & ~31) + perm32(R & 31)) : R;
        voffA[i] = (unsigned)(R * K + C) * 2u; voffB[i] = (unsigned)(Rb * K + C) * 2u; }
    const size_t kstep = (size_t)(BK * 2);
    const size_t hstep = (size_t)HALF * K * 2;
    const size_t tstep = 2 * hstep;
    const unsigned ldsw = (unsigned)wid * 1024u;
    const int aoff = lds_byte(wr * 64 + fr, fq * 8), boff = lds_byte(wc * 32 + fr, fq * 8);
#define PG8_SA(b, h) (((b) * 2 + (h)) * HTB)
#define PG8_SB(b, h) ((4 + (b) * 2 + (h)) * HTB)
#define PG8_STAGE(bufoff, gbase, voff) do { _Pragma("unroll") for (int _i = 0; _i < 2; ++_i) \
        __builtin_amdgcn_global_load_lds((const unsigned*)((const char*)(gbase) + (voff)[_i]), (PG8_LAS unsigned*)(lds + (bufoff) + ldsw + _i * 8192), 16, 0, 0); } while (0)
#define PG8_LDA(dst, b, h) do { _Pragma("unroll") for (int m = 0; m < 4; ++m) _Pragma("unroll") for (int k = 0; k < 2; ++k) dst[m][k] = *(const PG8_LAS bf16x8*)(lds + PG8_SA(b, h) + aoff + m * 2048 + k * 1024); } while (0)
#define PG8_LDB(dst, b, h) do { _Pragma("unroll") for (int n = 0; n < 2; ++n) _Pragma("unroll") for (int k = 0; k < 2; ++k) dst[n][k] = *(const PG8_LAS bf16x8*)(lds + PG8_SB(b, h) + boff + n * 2048 + k * 1024); } while (0)
#define PG8_MMA(ai, bj, At, Bt) do { __builtin_amdgcn_s_setprio(1); _Pragma("unroll") for (int m = 0; m < 4; ++m) _Pragma("unroll") for (int n = 0; n < 2; ++n) _Pragma("unroll") for (int k = 0; k < 2; ++k) \
        acc[ai][bj][m][n] = __builtin_amdgcn_mfma_f32_16x16x32_bf16(Bt[n][k], At[m][k], acc[ai][bj][m][n], 0, 0, 0); __builtin_amdgcn_s_setprio(0); } while (0)
#define PG8_WAIT_V(n) asm volatile("s_waitcnt vmcnt(" #n ")" ::: "memory")
#define PG8_WAIT_L(n) asm volatile("s_waitcnt lgkmcnt(" #n ")" ::: "memory")
#define PG8_BAR __builtin_amdgcn_s_barrier()
#define PG8_SCHED __builtin_amdgcn_sched_barrier(0)
    Unit cur, nxt; int ui = 0;
    if (!S.next(0, cur)) return;
    f32x4 acc[2][2][4][2];
#pragma unroll
    for (int a = 0; a < 2; ++a)
#pragma unroll
        for (int b = 0; b < 2; ++b)
#pragma unroll
            for (int m = 0; m < 4; ++m)
#pragma unroll
                for (int n = 0; n < 2; ++n) acc[a][b][m][n] = (f32x4){0.f, 0.f, 0.f, 0.f};
    bf16x8 At[4][2], B0[2][2], B1[2][2];
    const char* cA = (const char*)g.A + (size_t)cur.pm * tstep; const char* cB = (const char*)g.Bt + (size_t)cur.pn * tstep;
    S.a_ready(cur);
    PG8_STAGE(PG8_SB(0, 0), cB, voffB); PG8_STAGE(PG8_SA(0, 0), cA, voffA); PG8_STAGE(PG8_SB(0, 1), cB + hstep, voffB); PG8_STAGE(PG8_SA(0, 1), cA + hstep, voffA);
    if (wr == 1) PG8_BAR;
    PG8_WAIT_V(4); PG8_BAR;
    PG8_STAGE(PG8_SB(1, 0), cB + kstep, voffB); PG8_STAGE(PG8_SA(1, 0), cA + kstep, voffA); PG8_STAGE(PG8_SB(1, 1), cB + hstep + kstep, voffB);
    PG8_WAIT_V(6); PG8_BAR;
    PG8_STAMP();
    for (;;) {
        const bool has_next = S.next(ui + 1, nxt);
        const char* nA = has_next ? (const char*)g.A + (size_t)nxt.pm * tstep : cA; const char* nB = has_next ? (const char*)g.Bt + (size_t)nxt.pn * tstep : cB;
        for (int t = 0; t < nt; t += 2) {
            const bool last = (t == nt - 2);
            const char* a1 = cA + (size_t)(t + 1) * kstep;
            const char* a2 = last ? nA : cA + (size_t)(t + 2) * kstep; const char* b2 = last ? nB : cB + (size_t)(t + 2) * kstep;
            const char* a3 = a2 + kstep; const char* b3 = b2 + kstep;
            if (last && has_next) S.a_ready(nxt);
            PG8_LDB(B0, 0, 0); PG8_SCHED; PG8_LDA(At, 0, 0); PG8_STAGE(PG8_SA(1, 1), a1 + hstep, voffA);
            PG8_WAIT_L(8); PG8_BAR; PG8_WAIT_L(0); PG8_MMA(0, 0, At, B0); PG8_BAR; PG8_SCHED;
            PG8_LDB(B1, 0, 1); PG8_STAGE(PG8_SB(0, 0), b2, voffB);
            PG8_BAR; PG8_WAIT_L(0); PG8_MMA(0, 1, At, B1); PG8_BAR;
            PG8_LDA(At, 0, 1); PG8_STAGE(PG8_SA(0, 0), a2, voffA);
            PG8_BAR; PG8_WAIT_L(0); PG8_MMA(1, 0, At, B0); PG8_BAR; PG8_SCHED;
            PG8_STAGE(PG8_SB(0, 1), b2 + hstep, voffB);
            PG8_WAIT_V(6); PG8_BAR; PG8_MMA(1, 1, At, B1); PG8_BAR;
            PG8_LDB(B0, 1, 0); PG8_SCHED; PG8_LDA(At, 1, 0); PG8_STAGE(PG8_SA(0, 1), a2 + hstep, voffA);
            PG8_WAIT_L(8); PG8_BAR; PG8_WAIT_L(0); PG8_MMA(0, 0, At, B0); PG8_BAR; PG8_SCHED;
            PG8_LDB(B1, 1, 1); PG8_STAGE(PG8_SB(1, 0), b3, voffB);
            PG8_BAR; PG8_WAIT_L(0); PG8_MMA(0, 1, At, B1); PG8_BAR;
            PG8_LDA(At, 1, 1); PG8_STAGE(PG8_SA(1, 0), a3, voffA);
            PG8_BAR; PG8_WAIT_L(0); PG8_MMA(1, 0, At, B0); PG8_BAR; PG8_SCHED;
            PG8_STAGE(PG8_SB(1, 1), b3 + hstep, voffB);
            PG8_WAIT_V(6); PG8_BAR; PG8_MMA(1, 1, At, B1); PG8_BAR;
        }
        PG8_STAMP();
        if constexpr (!Epi::AFTER_DRAIN) { E(acc, cur, wr, wc, fr, fq); S.done(cur); }
        PG8_STAMP();
        if (!has_next) break;
#pragma unroll
        for (int a = 0; a < 2; ++a)
#pragma unroll
            for (int b = 0; b < 2; ++b)
#pragma unroll
                for (int m = 0; m < 4; ++m)
#pragma unroll
                    for (int n = 0; n < 2; ++n) acc[a][b][m][n] = (f32x4){0.f, 0.f, 0.f, 0.f};
        cur = nxt; cA = nA; cB = nB; ++ui;
    }
    PG8_WAIT_V(0);
    if (wr == 0) PG8_BAR;
    PG8_BAR;
    if constexpr (Epi::AFTER_DRAIN) { E.fused(acc, cur, wr, wc, fr, fq, lds, wid, lane); S.done(cur); }
    PG8_STAMP();
    if (STAMP && wid == 0) { stamps[lane] = lane < nts ? (((unsigned long long)(unsigned)ts_hi << 32) | (unsigned)ts_lo) : 0ull;
        if (lane == 62) stamps[62] = rt_entry; if (lane == 63) stamps[63] = (unsigned long long)wall_clock64(); }
#undef PG8_STAMP
#undef PG8_SA
#undef PG8_SB
#undef PG8_STAGE
#undef PG8_LDA
#undef PG8_LDB
#undef PG8_MMA
#undef PG8_WAIT_V
#undef PG8_WAIT_L
#undef PG8_BAR
#undef PG8_SCHED
}
}

using pg8::bf16_t; using pg8::bf16x8; using pg8::f32x4; using pg8::u32x4; using pg8::Unit; using pg8::cvt_pk_bf16;
#define LAS __attribute__((address_space(3)))
typedef short s16x4 __attribute__((ext_vector_type(4)));
typedef unsigned u32x2 __attribute__((ext_vector_type(2)));
typedef LAS unsigned char* ldsp;

constexpr int T = 8704, TP = 8192, DM = 2048, DFF = 5632;
constexpr float EPS = 1e-6f;
constexpr float LOG2E = 1.4426950408889634f;
constexpr float QSCALE = 0.08838834764831845f * LOG2E;

constexpr size_t O_Y = 0, O_SGP = 17825792, O_KP = 18350080, O_VP = 35127296, O_LFP = 51904512, O_SGS = 52035584,
                 O_KS = 56229888, O_VS = 57278464, O_LFS = 58327040;

constexpr size_t al256(size_t x) { return (x + 255) & ~(size_t)255; }
constexpr size_t WS_W1 = 0;
constexpr size_t WS_W2 = WS_W1 + (size_t)6400 * 2048 * 2;
constexpr size_t WS_W3 = WS_W2 + (size_t)2048 * 2048 * 2;
constexpr size_t WS_W4 = WS_W3 + 2 * (size_t)11264 * 2048 * 2;
constexpr size_t WS_W5 = WS_W4 + 2 * (size_t)2048 * 5632 * 2;
constexpr size_t WS_W6 = WS_W5 + (size_t)6400 * 2048 * 2;
constexpr size_t WS_HB = WS_W6 + (size_t)2048 * 2048 * 2;
constexpr size_t WS_SSQ = WS_HB + (size_t)T * 2048 * 2;
constexpr size_t WS_NBP = al256(WS_SSQ + 4 * (size_t)T * 4);
constexpr size_t WS_NBS = WS_NBP + (size_t)16 * 8192 * 4;
constexpr size_t WS_R = al256(WS_NBS + (size_t)128 * 2112 * 4);
constexpr size_t WS_QG = WS_R;
constexpr size_t WS_KG = WS_QG + (size_t)T * 1024 * 2;
constexpr size_t WS_VG = WS_KG + (size_t)T * 1024 * 2;
constexpr size_t WS_GG = WS_VG + (size_t)T * 2048 * 2;
constexpr size_t WS_GKL = WS_GG + (size_t)T * 2048 * 2;
constexpr size_t WS_QT = WS_GKL + (size_t)T * 16 * 4;
constexpr size_t WS_ATT = WS_QT + (size_t)T * 1024 * 2;
constexpr size_t WS_DEC = WS_ATT + (size_t)136 * 4 * 64 * 64 * 2;
constexpr size_t WS_DS = WS_DEC + (size_t)136 * 4 * 256 * 4;
constexpr size_t WS_OG = WS_DS + (size_t)128 * 4 * 512 * 256 * 2;
constexpr size_t WS_GLA_END = WS_OG + (size_t)T * 2048 * 2;
constexpr size_t WS_MID = WS_R;
constexpr size_t WS_QB = WS_MID + (size_t)T * 5632 * 2;
constexpr size_t WS_KPB = WS_QB + (size_t)T * 2048 * 2;
constexpr size_t WS_VPB = WS_KPB + (size_t)8192 * 2048 * 2;
constexpr size_t WS_KSB = WS_VPB + (size_t)8192 * 2048 * 2;
constexpr size_t WS_VSB = WS_KSB + (size_t)8 * 2112 * 2048 * 2;
constexpr size_t WS_LATE_END = WS_VSB + (size_t)8 * 2112 * 2048 * 2;
constexpr size_t WS_END = WS_LATE_END > WS_GLA_END ? WS_LATE_END : WS_GLA_END;

constexpr int LDS_BYTES = 147456;
constexpr int XCH_OFF = 131072;

struct Params {
    const float *x_prompt, *x_sample, *state_gla, *cache_k, *cache_v, *cache_logf, *g_mix, *g_ffn, *gla_w_in, *gla_w_gk2, *gla_b_gk,
        *gla_g_out, *gla_w_out, *kv_g, *kv_w, *kv_b_f, *kv_g_k, *fox_w_q, *fox_g_q, *fox_w_o, *ffn_w_in, *ffn_w_out;
    float* out; unsigned char* ws;
};

__device__ __forceinline__ int fresh_tid() { int t = threadIdx.x; asm volatile("" : "+v"(t)); return t; }
__device__ __forceinline__ float bf2f(unsigned x) { return __uint_as_float(x << 16); }
__device__ __forceinline__ bf16_t f2bf(float x) { return (bf16_t)(cvt_pk_bf16(x, 0.f) & 0xffffu); }
__device__ __forceinline__ float logsig(float z) { return fminf(z, 0.f) - log1pf(__expf(-fabsf(z))); }
__device__ __forceinline__ float silu(float g) { return g / (1.f + __expf(-g)); }
__device__ __forceinline__ bf16x8 trread2(const LAS bf16_t* p0, const LAS bf16_t* p1) {
    s16x4 a = __builtin_amdgcn_ds_read_tr16_b64_v4i16((LAS s16x4*)p0);
    s16x4 b = __builtin_amdgcn_ds_read_tr16_b64_v4i16((LAS s16x4*)p1);
    bf16x8 r; r[0] = a[0]; r[1] = a[1]; r[2] = a[2]; r[3] = a[3]; r[4] = b[0]; r[5] = b[1]; r[6] = b[2]; r[7] = b[3]; return r;
}
__device__ __forceinline__ f32x4 mfma16(bf16x8 a, bf16x8 b, f32x4 c) { return __builtin_amdgcn_mfma_f32_16x16x32_bf16(a, b, c, 0, 0, 0); }
__device__ __forceinline__ u32x2 pack4(f32x4 v) { u32x2 r; r.x = cvt_pk_bf16(v[0], v[1]); r.y = cvt_pk_bf16(v[2], v[3]); return r; }
__device__ __forceinline__ u32x4 pack8(f32x4 a, f32x4 b) { u32x4 r; r.x = cvt_pk_bf16(a[0], a[1]); r.y = cvt_pk_bf16(a[2], a[3]); r.z = cvt_pk_bf16(b[0], b[1]); r.w = cvt_pk_bf16(b[2], b[3]); return r; }

struct Epi1 {
    static constexpr bool PERM = true, AFTER_DRAIN = false;
    const float* ssq; bf16_t *qg, *kg, *vg, *gg; float* gkl;
    __device__ __forceinline__ void operator()(const f32x4 (&acc)[2][2][4][2], const Unit& u, int wr, int wc, int fr, int fq) const {
        const int pn = u.pn;
        bf16_t* base; int ld, cb; float sc = 1.f;
        if (pn < 4) { base = qg; ld = 1024; cb = pn * 256; sc = 0.0625f; }
        else if (pn < 8) { base = kg; ld = 1024; cb = (pn - 4) * 256; }
        else if (pn < 16) { base = vg; ld = 2048; cb = (pn - 8) * 256; }
        else { base = gg; ld = 2048; cb = (pn - 16) * 256; }
#pragma unroll
        for (int ai = 0; ai < 2; ++ai)
#pragma unroll
            for (int m = 0; m < 4; ++m) {
                const int row = u.pm * 256 + ai * 128 + wr * 64 + m * 16 + fr;
                const float rs = rsqrtf(ssq[row] * (1.f / 2048.f) + EPS) * sc;
                if (pn < 24) {
#pragma unroll
                    for (int bj = 0; bj < 2; ++bj) {
                        const int col = cb + bj * 128 + wc * 32 + fq * 8;
                        *(u32x4*)(base + (size_t)row * ld + col) = pack8(acc[ai][bj][m][0] * rs, acc[ai][bj][m][1] * rs);
                    }
                } else if (wc == 0 && fq < 2) {
                    float* gp = gkl + (size_t)row * 16 + fq * 8;
                    *(f32x4*)gp = acc[ai][0][m][0] * rs; *(f32x4*)(gp + 4) = acc[ai][0][m][1] * rs;
                }
            }
    }
};

template <bool LAST> struct EpiRes {
    static constexpr bool PERM = true, AFTER_DRAIN = false;
    const float *res_p, *res_s; float* y; bf16_t* hb; float* ssq_out;
    __device__ __forceinline__ void operator()(const f32x4 (&acc)[2][2][4][2], const Unit& u, int wr, int wc, int fr, int fq) const {
#pragma unroll
        for (int ai = 0; ai < 2; ++ai)
#pragma unroll
            for (int m = 0; m < 4; ++m) {
                const int row = u.pm * 256 + ai * 128 + wr * 64 + m * 16 + fr;
                const float* rp = row < TP ? res_p + (size_t)row * DM : res_s + (size_t)(row - TP) * DM;
                float ss = 0.f;
#pragma unroll
                for (int bj = 0; bj < 2; ++bj) {
                    const int col = u.pn * 256 + bj * 128 + wc * 32 + fq * 8;
                    const f32x4 v0 = acc[ai][bj][m][0] + *(const f32x4*)(rp + col), v1 = acc[ai][bj][m][1] + *(const f32x4*)(rp + col + 4);
                    float* yp = y + (size_t)row * DM + col;
                    *(f32x4*)yp = v0; *(f32x4*)(yp + 4) = v1;
                    if (!LAST) {
                        *(u32x4*)(hb + (size_t)row * DM + col) = pack8(v0, v1);
                        ss += v0[0] * v0[0] + v0[1] * v0[1] + v0[2] * v0[2] + v0[3] * v0[3] + v1[0] * v1[0] + v1[1] * v1[1] + v1[2] * v1[2] + v1[3] * v1[3];
                    }
                }
                if (!LAST) {
                    ss += __shfl_xor(ss, 16); ss += __shfl_xor(ss, 32);
                    if (fq == 0) atomicAdd(ssq_out + row, ss);
                }
            }
    }
};

struct EpiGlu {
    static constexpr bool PERM = true, AFTER_DRAIN = false;
    const float* ssq; bf16_t* mid;
    __device__ __forceinline__ void operator()(const f32x4 (&acc)[2][2][4][2], const Unit& u, int wr, int wc, int fr, int fq) const {
#pragma unroll
        for (int ai = 0; ai < 2; ++ai)
#pragma unroll
            for (int m = 0; m < 4; ++m) {
                const int row = u.pm * 256 + ai * 128 + wr * 64 + m * 16 + fr;
                const float rs = rsqrtf(ssq[row] * (1.f / 2048.f) + EPS);
#pragma unroll
                for (int bj = 0; bj < 2; ++bj) {
                    const f32x4 g = acc[ai][bj][m][0] * rs, up = acc[ai][bj][m][1] * rs;
                    f32x4 o;
#pragma unroll
                    for (int i = 0; i < 4; ++i) o[i] = silu(g[i]) * up[i];
                    const int col = u.pn * 128 + bj * 64 + wc * 16 + fq * 4;
                    *(u32x2*)(mid + (size_t)row * DFF + col) = pack4(o);
                }
            }
    }
};

struct EpiKvq {
    static constexpr bool PERM = true, AFTER_DRAIN = false;
    const float* ssq; float* out; bf16_t *qb, *kpb, *vpb, *ksb, *vsb; const float *g_k, *g_q, *b_f; ldsp lds;
    __device__ __forceinline__ void operator()(const f32x4 (&acc)[2][2][4][2], const Unit& u, int wr, int wc, int fr, int fq) const {
        const int pn = u.pn;
        LAS float* xch = (LAS float*)(lds + XCH_OFF);
        const bool normed = (pn < 8) || (pn >= 16 && pn < 24);
        if (normed) {
#pragma unroll
            for (int ai = 0; ai < 2; ++ai)
#pragma unroll
                for (int m = 0; m < 4; ++m) {
                    const int rl = ai * 128 + wr * 64 + m * 16 + fr;
#pragma unroll
                    for (int bj = 0; bj < 2; ++bj) {
                        const f32x4 a = acc[ai][bj][m][0], b = acc[ai][bj][m][1];
                        float s = a[0] * a[0] + a[1] * a[1] + a[2] * a[2] + a[3] * a[3] + b[0] * b[0] + b[1] * b[1] + b[2] * b[2] + b[3] * b[3];
                        s += __shfl_xor(s, 16); s += __shfl_xor(s, 32);
                        if (fq == 0) xch[rl * 8 + bj * 4 + wc] = s;
                    }
                }
            asm volatile("s_waitcnt lgkmcnt(0)" ::: "memory");
            __builtin_amdgcn_s_barrier();
            asm volatile("" ::: "memory");
        }
#pragma unroll
        for (int ai = 0; ai < 2; ++ai)
#pragma unroll
            for (int m = 0; m < 4; ++m) {
                const int rl = ai * 128 + wr * 64 + m * 16 + fr;
                const int row = u.pm * 256 + rl;
                const float rs = rsqrtf(ssq[row] * (1.f / 2048.f) + EPS);
                const bool prm = row < TP;
                const int sr = row - TP;
                if (normed) {
                    const f32x4 x0 = *(const LAS f32x4*)(xch + rl * 8), x1 = *(const LAS f32x4*)(xch + rl * 8 + 4);
                    const float hs0 = (x0[0] + x0[1] + x0[2] + x0[3]) * rs * rs, hs1 = (x1[0] + x1[1] + x1[2] + x1[3]) * rs * rs;
                    const bool isq = pn >= 16;
                    const float* gv = isq ? g_q : g_k;
                    const f32x4 g0 = *(const f32x4*)(gv + wc * 32 + fq * 8), g1 = *(const f32x4*)(gv + wc * 32 + fq * 8 + 4);
#pragma unroll
                    for (int bj = 0; bj < 2; ++bj) {
                        const float hr = rsqrtf((bj ? hs1 : hs0) * (1.f / 128.f) + EPS) * rs * (isq ? QSCALE : 1.f);
                        const f32x4 v0 = acc[ai][bj][m][0] * hr * g0, v1 = acc[ai][bj][m][1] * hr * g1;
                        if (isq) {
                            const int col = (pn - 16) * 256 + bj * 128 + wc * 32 + fq * 8;
                            *(u32x4*)(qb + (size_t)row * DM + col) = pack8(v0, v1);
                        } else {
                            const int col = pn * 256 + bj * 128 + wc * 32 + fq * 8;
                            float* op = prm ? out + O_KP + (size_t)row * DM + col : out + O_KS + (size_t)sr * DM + col;
                            *(f32x4*)op = v0; *(f32x4*)(op + 4) = v1;
                            bf16_t* bp = prm ? kpb + (size_t)row * DM + col : ksb + ((size_t)(sr >> 6) * 2112 + 2048 + (sr & 63)) * DM + col;
                            *(u32x4*)bp = pack8(v0, v1);
                        }
                    }
                } else if (pn < 16) {
#pragma unroll
                    for (int bj = 0; bj < 2; ++bj) {
                        const f32x4 v0 = acc[ai][bj][m][0] * rs, v1 = acc[ai][bj][m][1] * rs;
                        const int col = (pn - 8) * 256 + bj * 128 + wc * 32 + fq * 8;
                        float* op = prm ? out + O_VP + (size_t)row * DM + col : out + O_VS + (size_t)sr * DM + col;
                        *(f32x4*)op = v0; *(f32x4*)(op + 4) = v1;
                        bf16_t* bp = prm ? vpb + (size_t)row * DM + col : vsb + ((size_t)(sr >> 6) * 2112 + 2048 + (sr & 63)) * DM + col;
                        *(u32x4*)bp = pack8(v0, v1);
                    }
                } else if (wc == 0 && fq < 2) {
                    float* op = prm ? out + O_LFP + (size_t)row * 16 + fq * 8 : out + O_LFS + (size_t)sr * 16 + fq * 8;
                    f32x4 v0 = acc[ai][0][m][0] * rs, v1 = acc[ai][0][m][1] * rs;
                    const f32x4 b0 = *(const f32x4*)(b_f + fq * 8), b1 = *(const f32x4*)(b_f + fq * 8 + 4);
#pragma unroll
                    for (int i = 0; i < 4; ++i) { v0[i] = logsig(v0[i] + b0[i]); v1[i] = logsig(v1[i] + b1[i]); }
                    *(f32x4*)op = v0; *(f32x4*)(op + 4) = v1;
                }
                __builtin_amdgcn_sched_barrier(0);
            }
    }
};

__device__ __forceinline__ void prep_phase(ldsp lds, const Params& p) {
    const int tid = fresh_tid(), lane = tid & 63, w = tid >> 6;
    LAS bf16_t* tile = (LAS bf16_t*)lds;
    for (int tix = blockIdx.x; tix < 25344; tix += gridDim.x) {
        int mat, lt;
        if (tix < 3200) { mat = 0; lt = tix; } else if (tix < 4224) { mat = 1; lt = tix - 3200; } else if (tix < 9856) { mat = 2; lt = tix - 4224; }
        else if (tix < 15488) { mat = 3; lt = tix - 9856; } else if (tix < 18304) { mat = 4; lt = tix - 15488; } else if (tix < 21120) { mat = 5; lt = tix - 18304; }
        else if (tix < 24320) { mat = 6; lt = tix - 21120; } else { mat = 7; lt = tix - 24320; }
        const int K = (mat == 4 || mat == 5) ? 5632 : 2048;
        const int nkt = K / 64;
        const int nt = lt / nkt, kt = lt - nt * nkt;
        const int n0 = nt * 64, k0 = kt * 64;
        const float* src; int ld; const float* g = nullptr; bf16_t* dst;
        const int n = n0 + (tid & 63);
        int col;
        switch (mat) {
            case 0: src = p.gla_w_in; ld = 6160; g = p.g_mix; dst = (bf16_t*)(p.ws + WS_W1); col = n < 6160 ? n : -1; break;
            case 1: src = p.gla_w_out; ld = 2048; dst = (bf16_t*)(p.ws + WS_W2); col = n; break;
            case 2: case 3: { const int l = mat - 2; src = p.ffn_w_in + (size_t)l * 2048 * 11264; ld = 11264; g = p.g_ffn + l * 2048; dst = (bf16_t*)(p.ws + WS_W3) + (size_t)l * 11264 * 2048;
                      col = ((n >> 2) & 1) * 5632 + 4 * (n >> 3) + (n & 3); break; }
            case 4: case 5: { const int l = mat - 4; src = p.ffn_w_out + (size_t)l * 5632 * 2048; ld = 2048; dst = (bf16_t*)(p.ws + WS_W4) + (size_t)l * 2048 * 5632; col = n; break; }
            case 6: dst = (bf16_t*)(p.ws + WS_W5);
                    if (n < 4096) { src = p.kv_w; ld = 4112; g = p.kv_g; col = n; }
                    else if (n < 6144) { src = p.fox_w_q; ld = 2048; g = p.g_mix + 2048; col = n - 4096; }
                    else { src = p.kv_w; ld = 4112; g = p.kv_g; col = n < 6160 ? 4096 + (n - 6144) : -1; }
                    break;
            default: src = p.fox_w_o; ld = 2048; dst = (bf16_t*)(p.ws + WS_W6); col = n; break;
        }
        float v[8];
#pragma unroll
        for (int i = 0; i < 8; ++i) {
            const int k = k0 + w + 8 * i;
            float x = col >= 0 ? src[(size_t)k * ld + col] : 0.f;
            if (g) x *= g[k];
            v[i] = x;
        }
#pragma unroll
        for (int i = 0; i < 8; ++i) tile[(tid & 63) * 66 + w + 8 * i] = f2bf(v[i]);
        __syncthreads();
        {
            const int nn = tid >> 3, kc = (tid & 7) * 8;
            const LAS unsigned* sp = (const LAS unsigned*)(tile + nn * 66 + kc);
            u32x4 o; o.x = sp[0]; o.y = sp[1]; o.z = sp[2]; o.w = sp[3];
            *(u32x4*)(dst + (size_t)(n0 + nn) * K + k0 + kc) = o;
        }
        __syncthreads();
    }
    bf16_t* hb = (bf16_t*)(p.ws + WS_HB);
    float* ssq = (float*)(p.ws + WS_SSQ);
    for (int rb = blockIdx.x; rb < T / 8; rb += gridDim.x) {
        const int row = rb * 8 + w;
        const float* src = row < TP ? p.x_prompt + (size_t)row * DM : p.x_sample + (size_t)(row - TP) * DM;
        float ss = 0.f;
#pragma unroll
        for (int i = 0; i < 8; ++i) {
            const f32x4 x = *(const f32x4*)(src + (i * 64 + lane) * 4);
            ss += x[0] * x[0] + x[1] * x[1] + x[2] * x[2] + x[3] * x[3];
            *(u32x2*)(hb + (size_t)row * DM + (i * 64 + lane) * 4) = pack4(x);
        }
#pragma unroll
        for (int o = 32; o >= 1; o >>= 1) ss += __shfl_xor(ss, o);
        if (lane == 0) ssq[row] = ss;
    }
    for (int i = blockIdx.x * 512 + tid; i < 3 * T; i += gridDim.x * 512) ssq[T + i] = 0.f;
}

constexpr int QP = 264, VPI = 528, KDP = 72;
__device__ __forceinline__ void gla_c1(ldsp lds, const Params& p, int ci, int h) {
    const int tid = fresh_tid(), lane = tid & 63, w = tid >> 6, quad = lane >> 4, l15 = lane & 15;
    const int r0 = ci < 128 ? ci * 64 : TP + (ci - 128) * 64;
    LAS bf16_t* sQ = (LAS bf16_t*)lds;
    LAS bf16_t* sK = sQ + 64 * QP;
    LAS bf16_t* sV = (LAS bf16_t*)lds;
    LAS bf16_t* sKd = (LAS bf16_t*)(lds + 67584);
    LAS float* sG = (LAS float*)(lds + 67584 + 36864);
    LAS float* sH = sG + 1024;
    LAS float* sDec = sH + 512;
    const bf16_t* qg = (const bf16_t*)(p.ws + WS_QG); const bf16_t* kg = (const bf16_t*)(p.ws + WS_KG); const bf16_t* vg = (const bf16_t*)(p.ws + WS_VG);
    const float* gkl = (const float*)(p.ws + WS_GKL);
    bf16_t* qt = (bf16_t*)(p.ws + WS_QT); bf16_t* attb = (bf16_t*)(p.ws + WS_ATT); float* dec = (float*)(p.ws + WS_DEC); bf16_t* dsb = (bf16_t*)(p.ws + WS_DS);
    if (tid < 256) *(LAS f32x4*)(sG + tid * 4) = *(const f32x4*)(gkl + (size_t)(r0 + (tid >> 2)) * 16 + (tid & 3) * 4);
    __syncthreads();
    const int d = tid & 255, hf = tid >> 8;
    float bv[32];
    {
        float w2[16];
#pragma unroll
        for (int r = 0; r < 16; ++r) w2[r] = p.gla_w_gk2[r * 1024 + h * 256 + d];
        const float bias = p.gla_b_gk[h * 256 + d];
        float run = 0.f;
#pragma unroll
        for (int i = 0; i < 32; ++i) {
            const int t = hf * 32 + i;
            float z = bias;
#pragma unroll
            for (int r4 = 0; r4 < 4; ++r4) { const f32x4 gq = *(const LAS f32x4*)(sG + t * 16 + r4 * 4); z += gq[0] * w2[r4 * 4] + gq[1] * w2[r4 * 4 + 1] + gq[2] * w2[r4 * 4 + 2] + gq[3] * w2[r4 * 4 + 3]; }
            run += logsig(z) * 0.0625f;
            bv[i] = run;
        }
        sH[hf * 256 + d] = run;
    }
    __syncthreads();
    const float h0 = sH[d], h1 = sH[256 + d];
    const float blast = h0 + h1, boff = hf ? h0 : 0.f;
    if (hf == 0) { const float dv = __expf(blast); sDec[d] = dv; dec[(size_t)(ci * 4 + h) * 256 + d] = dv; }
#pragma unroll
    for (int i8 = 0; i8 < 4; ++i8) {
        float kd[8];
#pragma unroll
        for (int j = 0; j < 8; ++j) {
            const int i = i8 * 8 + j, t = hf * 32 + i;
            const float b = bv[i] + boff;
            const float qv = bf2f(qg[(size_t)(r0 + t) * 1024 + h * 256 + d]), kv = bf2f(kg[(size_t)(r0 + t) * 1024 + h * 256 + d]);
            const bf16_t qs = f2bf(qv * __expf(b));
            sQ[t * QP + d] = qs; qt[(size_t)(r0 + t) * 1024 + h * 256 + d] = qs;
            sK[t * QP + d] = f2bf(kv * __expf(-b));
            kd[j] = kv * __expf(blast - b);
        }
        u32x4 o; o.x = cvt_pk_bf16(kd[0], kd[1]); o.y = cvt_pk_bf16(kd[2], kd[3]); o.z = cvt_pk_bf16(kd[4], kd[5]); o.w = cvt_pk_bf16(kd[6], kd[7]);
        *(LAS u32x4*)(sKd + d * KDP + hf * 32 + i8 * 8) = o;
    }
    __syncthreads();
    {
        const int tt = w >> 1;
#pragma unroll
        for (int s2 = 0; s2 < 2; ++s2) {
            const int st = (w & 1) * 2 + s2;
            f32x4 a4 = {0.f, 0.f, 0.f, 0.f};
#pragma unroll
            for (int ks = 0; ks < 8; ++ks) {
                const bf16x8 ka = *(const LAS bf16x8*)(sK + (16 * st + l15) * QP + 32 * ks + 8 * quad);
                const bf16x8 qb = *(const LAS bf16x8*)(sQ + (16 * tt + l15) * QP + 32 * ks + 8 * quad);
                a4 = mfma16(ka, qb, a4);
            }
            const int t = 16 * tt + l15, s0 = 16 * st + 4 * quad;
#pragma unroll
            for (int j = 0; j < 4; ++j) if (s0 + j > t) a4[j] = 0.f;
            *(u32x2*)(attb + ((size_t)(ci * 4 + h) * 64 + t) * 64 + s0) = pack4(a4);
        }
    }
    __syncthreads();
#pragma unroll
    for (int i = 0; i < 8; ++i) {
        const int ch = tid + 512 * i, s = ch >> 6, c16 = ch & 63;
        *(LAS u32x4*)(sV + s * VPI + c16 * 8) = *(const u32x4*)(vg + (size_t)(r0 + s) * 2048 + h * 512 + c16 * 8);
    }
    __syncthreads();
    {
        const int q4 = (lane >> 2) & 3, p4 = lane & 3;
        bf16x8 vf[4][2];
#pragma unroll
        for (int vt = 0; vt < 4; ++vt)
#pragma unroll
            for (int ks = 0; ks < 2; ++ks) {
                const LAS bf16_t* a0 = sV + (32 * ks + 8 * quad + q4) * VPI + 64 * w + 16 * vt + 4 * p4;
                vf[vt][ks] = trread2(a0, a0 + 4 * VPI);
            }
        const bool prm = ci < 128;
        for (int dg = 0; dg < 4; ++dg) {
            f32x4 acc[4][4];
#pragma unroll
            for (int a = 0; a < 4; ++a)
#pragma unroll
                for (int b = 0; b < 4; ++b) acc[a][b] = (f32x4){0.f, 0.f, 0.f, 0.f};
#pragma unroll
            for (int dt = 0; dt < 4; ++dt)
#pragma unroll
                for (int ks = 0; ks < 2; ++ks) {
                    const bf16x8 kf = *(const LAS bf16x8*)(sKd + (64 * dg + 16 * dt + l15) * KDP + 32 * ks + 8 * quad);
#pragma unroll
                    for (int vt = 0; vt < 4; ++vt) acc[vt][dt] = prm ? mfma16(kf, vf[vt][ks], acc[vt][dt]) : mfma16(vf[vt][ks], kf, acc[vt][dt]);
                }
            if (prm) {
#pragma unroll
                for (int vt = 0; vt < 4; ++vt)
#pragma unroll
                    for (int dt = 0; dt < 4; ++dt)
                        *(u32x2*)(dsb + ((size_t)(ci * 4 + h) * 512 + 64 * w + 16 * vt + l15) * 256 + 64 * dg + 16 * dt + 4 * quad) = pack4(acc[vt][dt]);
            } else {
                const int b = ci - 128;
#pragma unroll
                for (int vt = 0; vt < 4; ++vt)
#pragma unroll
                    for (int dt = 0; dt < 4; ++dt) {
                        const int dd = 64 * dg + 16 * dt + l15, v = 64 * w + 16 * vt + 4 * quad;
                        const size_t off = ((size_t)(b * 4 + h) * 256 + dd) * 512 + v;
                        const f32x4 s0 = *(const f32x4*)(p.state_gla + off);
                        *(f32x4*)(p.out + O_SGS + off) = s0 * sDec[dd] + acc[vt][dt];
                    }
            }
        }
    }
    __syncthreads();
}

__device__ __forceinline__ void gla_c2(const Params& p) {
    bf16_t* dsb = (bf16_t*)(p.ws + WS_DS); const float* dec = (const float*)(p.ws + WS_DEC);
    for (int e = blockIdx.x * 512 + fresh_tid(); e < 131072; e += gridDim.x * 512) {
        const int h = e >> 15, rem = e & 32767, v = rem >> 6, d4 = (rem & 63) * 4;
        f32x4 s = {0.f, 0.f, 0.f, 0.f};
        for (int n0 = 0; n0 < 128; n0 += 8) {
            u32x2 x[8]; f32x4 dc[8];
#pragma unroll
            for (int i = 0; i < 8; ++i) {
                x[i] = *(const u32x2*)(dsb + ((size_t)((n0 + i) * 4 + h) * 512 + v) * 256 + d4);
                dc[i] = *(const f32x4*)(dec + (size_t)((n0 + i) * 4 + h) * 256 + d4);
            }
#pragma unroll
            for (int i = 0; i < 8; ++i) {
                *(u32x2*)(dsb + ((size_t)((n0 + i) * 4 + h) * 512 + v) * 256 + d4) = pack4(s);
                f32x4 dx; dx[0] = bf2f(x[i].x & 0xffffu); dx[1] = bf2f(x[i].x >> 16); dx[2] = bf2f(x[i].y & 0xffffu); dx[3] = bf2f(x[i].y >> 16);
                s = dc[i] * s + dx;
            }
        }
#pragma unroll
        for (int i = 0; i < 4; ++i) p.out[O_SGP + ((size_t)(h * 256 + d4 + i)) * 512 + v] = s[i];
    }
}

__device__ __forceinline__ void gla_c3(ldsp lds, const Params& p, int ci, int h) {
    const int tid = fresh_tid(), lane = tid & 63, w = tid >> 6, quad = lane >> 4, l15 = lane & 15;
    const int r0 = ci < 128 ? ci * 64 : TP + (ci - 128) * 64;
    LAS bf16_t* sQ = (LAS bf16_t*)lds;
    LAS bf16_t* sA = (LAS bf16_t*)(lds + 33792);
    LAS bf16_t* sV = (LAS bf16_t*)(lds + 43008);
    LAS float* sR = (LAS float*)(lds + 110592);
    const bf16_t* vg = (const bf16_t*)(p.ws + WS_VG); const bf16_t* gg = (const bf16_t*)(p.ws + WS_GG);
    const bf16_t* qt = (const bf16_t*)(p.ws + WS_QT); const bf16_t* attb = (const bf16_t*)(p.ws + WS_ATT); const bf16_t* dsb = (const bf16_t*)(p.ws + WS_DS);
    bf16_t* og = (bf16_t*)(p.ws + WS_OG);
#pragma unroll
    for (int i = 0; i < 4; ++i) {
        const int ch = tid + 512 * i, t = ch >> 5, c = ch & 31;
        *(LAS u32x4*)(sQ + t * QP + c * 8) = *(const u32x4*)(qt + (size_t)(r0 + t) * 1024 + h * 256 + c * 8);
    }
    { const int t = tid >> 3, c = tid & 7; *(LAS u32x4*)(sA + t * KDP + c * 8) = *(const u32x4*)(attb + ((size_t)(ci * 4 + h) * 64 + t) * 64 + c * 8); }
#pragma unroll
    for (int i = 0; i < 8; ++i) {
        const int ch = tid + 512 * i, s = ch >> 6, c16 = ch & 63;
        *(LAS u32x4*)(sV + s * VPI + c16 * 8) = *(const u32x4*)(vg + (size_t)(r0 + s) * 2048 + h * 512 + c16 * 8);
    }
    __syncthreads();
    f32x4 acc[4][4];
#pragma unroll
    for (int a = 0; a < 4; ++a)
#pragma unroll
        for (int b = 0; b < 4; ++b) acc[a][b] = (f32x4){0.f, 0.f, 0.f, 0.f};
    const int q4 = (lane >> 2) & 3, p4 = lane & 3;
#pragma unroll
    for (int ks = 0; ks < 2; ++ks) {
        bf16x8 af[4], vf[4];
#pragma unroll
        for (int tt = 0; tt < 4; ++tt) af[tt] = *(const LAS bf16x8*)(sA + (16 * tt + l15) * KDP + 32 * ks + 8 * quad);
#pragma unroll
        for (int vt = 0; vt < 4; ++vt) { const LAS bf16_t* a0 = sV + (32 * ks + 8 * quad + q4) * VPI + 64 * w + 16 * vt + 4 * p4; vf[vt] = trread2(a0, a0 + 4 * VPI); }
#pragma unroll
        for (int tt = 0; tt < 4; ++tt)
#pragma unroll
            for (int vt = 0; vt < 4; ++vt) acc[tt][vt] = mfma16(vf[vt], af[tt], acc[tt][vt]);
    }
    const bool prm = ci < 128;
    for (int ks = 0; ks < 8; ++ks) {
        bf16x8 qf[4], sf[4];
#pragma unroll
        for (int tt = 0; tt < 4; ++tt) qf[tt] = *(const LAS bf16x8*)(sQ + (16 * tt + l15) * QP + 32 * ks + 8 * quad);
        if (prm) {
#pragma unroll
            for (int vt = 0; vt < 4; ++vt) sf[vt] = *(const bf16x8*)(dsb + ((size_t)(ci * 4 + h) * 512 + 64 * w + 16 * vt + l15) * 256 + 32 * ks + 8 * quad);
        } else {
            const int b = ci - 128;
#pragma unroll
            for (int vt = 0; vt < 4; ++vt) {
                const float* sp = p.state_gla + ((size_t)(b * 4 + h) * 256 + 32 * ks + 8 * quad) * 512 + 64 * w + 16 * vt + l15;
                float f[8];
#pragma unroll
                for (int j = 0; j < 8; ++j) f[j] = sp[(size_t)j * 512];
                union { u32x4 u; bf16x8 v; } cv; cv.u.x = cvt_pk_bf16(f[0], f[1]); cv.u.y = cvt_pk_bf16(f[2], f[3]); cv.u.z = cvt_pk_bf16(f[4], f[5]); cv.u.w = cvt_pk_bf16(f[6], f[7]);
                sf[vt] = cv.v;
            }
        }
#pragma unroll
        for (int tt = 0; tt < 4; ++tt)
#pragma unroll
            for (int vt = 0; vt < 4; ++vt) acc[tt][vt] = mfma16(sf[vt], qf[tt], acc[tt][vt]);
    }
#pragma unroll
    for (int tt = 0; tt < 4; ++tt) {
        float ss = 0.f;
#pragma unroll
        for (int vt = 0; vt < 4; ++vt)
#pragma unroll
            for (int j = 0; j < 4; ++j) ss += acc[tt][vt][j] * acc[tt][vt][j];
        ss += __shfl_xor(ss, 16); ss += __shfl_xor(ss, 32);
        if (quad == 0) sR[(16 * tt + l15) * 8 + w] = ss;
    }
    __syncthreads();
#pragma unroll
    for (int tt = 0; tt < 4; ++tt) {
        const int t = 16 * tt + l15;
        const f32x4 x0 = *(const LAS f32x4*)(sR + t * 8), x1 = *(const LAS f32x4*)(sR + t * 8 + 4);
        const float rs = rsqrtf((x0[0] + x0[1] + x0[2] + x0[3] + x1[0] + x1[1] + x1[2] + x1[3]) * (1.f / 512.f) + EPS);
#pragma unroll
        for (int vt = 0; vt < 4; ++vt) {
            const int v = 64 * w + 16 * vt + 4 * quad;
            const u32x2 gr = *(const u32x2*)(gg + (size_t)(r0 + t) * 2048 + h * 512 + v);
            const f32x4 go = *(const f32x4*)(p.gla_g_out + v);
            f32x4 o;
            o[0] = acc[tt][vt][0] * rs * go[0] * silu(bf2f(gr.x & 0xffffu));
            o[1] = acc[tt][vt][1] * rs * go[1] * silu(bf2f(gr.x >> 16));
            o[2] = acc[tt][vt][2] * rs * go[2] * silu(bf2f(gr.y & 0xffffu));
            o[3] = acc[tt][vt][3] * rs * go[3] * silu(bf2f(gr.y >> 16));
            *(u32x2*)(og + (size_t)(r0 + t) * 2048 + h * 512 + v) = pack4(o);
        }
    }
    __syncthreads();
}

__device__ __forceinline__ void cum_phase(const Params& p) {
    const int tid = fresh_tid(), lane = tid & 63, w = tid >> 6;
    float* nbp = (float*)(p.ws + WS_NBP); float* nbs = (float*)(p.ws + WS_NBS);
    for (int s = w * gridDim.x + blockIdx.x; s < 144; s += 8 * gridDim.x) {
        const bool prm = s < 16;
        const int L = prm ? 8192 : 2112, seg = prm ? 128 : 33;
        const int b = (s - 16) >> 4, hh = prm ? s : ((s - 16) & 15);
        const int lo = lane * seg, hi = lo + seg;
        float sum = 0.f;
        for (int pos = lo; pos < hi; ++pos) {
            const float v = prm ? p.out[O_LFP + (size_t)pos * 16 + hh]
                                : (pos < 2048 ? p.cache_logf[((size_t)b * 2048 + pos) * 16 + hh] : p.out[O_LFS + ((size_t)b * 64 + pos - 2048) * 16 + hh]);
            sum += v;
        }
        float inc = sum;
#pragma unroll
        for (int o = 1; o < 64; o <<= 1) { const float t = __shfl_up(inc, o); if (lane >= o) inc += t; }
        float run = inc - sum;
        float* dst = prm ? nbp + (size_t)hh * 8192 : nbs + (size_t)(b * 16 + hh) * 2112;
        for (int pos = lo; pos < hi; ++pos) {
            const float v = prm ? p.out[O_LFP + (size_t)pos * 16 + hh]
                                : (pos < 2048 ? p.cache_logf[((size_t)b * 2048 + pos) * 16 + hh] : p.out[O_LFS + ((size_t)b * 64 + pos - 2048) * 16 + hh]);
            run += v;
            dst[pos] = -run * LOG2E;
        }
        (void)L;
    }
    bf16_t* ksb = (bf16_t*)(p.ws + WS_KSB); bf16_t* vsb = (bf16_t*)(p.ws + WS_VSB);
    for (size_t c = (size_t)blockIdx.x * 512 + tid; c < (size_t)8 * 2048 * 256; c += (size_t)gridDim.x * 512) {
        const size_t rowi = c >> 8, cc = (c & 255) * 8;
        const size_t bb = rowi >> 11, pos = rowi & 2047;
        const float* ks = p.cache_k + rowi * 2048 + cc; const float* vs = p.cache_v + rowi * 2048 + cc;
        const f32x4 k0 = *(const f32x4*)ks, k1 = *(const f32x4*)(ks + 4), v0 = *(const f32x4*)vs, v1 = *(const f32x4*)(vs + 4);
        *(u32x4*)(ksb + (bb * 2112 + pos) * 2048 + cc) = pack8(k0, k1);
        *(u32x4*)(vsb + (bb * 2112 + pos) * 2048 + cc) = pack8(v0, v1);
    }
}

constexpr int AKP = 136, AVP = 144;
template <int QT, int NH>
__device__ __forceinline__ void attn_item(ldsp lds, bf16_t* qo, int qrow_wave, int qpos_wave, int hcol_wave, int hsel,
                                          const bf16_t* kbase, const bf16_t* vbase, const float* nb0, const float* nb1, int ntiles) {
    const int tid = fresh_tid(), lane = tid & 63, quad = lane >> 4, l15 = lane & 15;
    constexpr int STG = NH * (64 * AKP * 2 + 64 * AVP * 2 + 256);
    constexpr int KOFF = 0, VOFF = NH * 64 * AKP * 2, NOFF = VOFF + NH * 64 * AVP * 2;
    constexpr int NC = 2 * NH;
    bf16x8 qf[QT][4];
#pragma unroll
    for (int qt = 0; qt < QT; ++qt)
#pragma unroll
        for (int ks = 0; ks < 4; ++ks) qf[qt][ks] = *(const bf16x8*)(qo + (size_t)(qrow_wave + 16 * qt + l15) * DM + hcol_wave + 32 * ks + 8 * quad);
    f32x4 O[QT][8];
#pragma unroll
    for (int qt = 0; qt < QT; ++qt)
#pragma unroll
        for (int dt = 0; dt < 8; ++dt) O[qt][dt] = (f32x4){0.f, 0.f, 0.f, 0.f};
    float mrow[QT], lsum[QT];
#pragma unroll
    for (int qt = 0; qt < QT; ++qt) { mrow[qt] = -1e30f; lsum[qt] = 0.f; }
    u32x4 kreg[NC], vreg[NC]; float nreg = 0.f;
    const int q4 = (lane >> 2) & 3, p4 = lane & 3;
    const int qmax = qpos_wave + 16 * QT - 1;
#define ATT_LOAD(it) do { _Pragma("unroll") for (int i = 0; i < NC; ++i) { const int ch = tid + 512 * i, key = ch / (16 * NH), c = ch % (16 * NH); \
            kreg[i] = *(const u32x4*)(kbase + (size_t)((it) * 64 + key) * DM + c * 8); vreg[i] = *(const u32x4*)(vbase + (size_t)((it) * 64 + key) * DM + c * 8); } \
        if (tid < 64 * NH) nreg = (tid < 64 ? nb0 : nb1)[(it) * 64 + (tid & 63)]; } while (0)
#define ATT_STORE(st) do { ldsp sb = lds + (st) * STG; _Pragma("unroll") for (int i = 0; i < NC; ++i) { const int ch = tid + 512 * i, key = ch / (16 * NH), c = ch % (16 * NH), hh = c >> 4, cc = c & 15; \
            *(LAS u32x4*)(sb + KOFF + ((hh * 64 + key) * AKP + cc * 8) * 2) = kreg[i]; *(LAS u32x4*)(sb + VOFF + ((hh * 64 + key) * AVP + cc * 8) * 2) = vreg[i]; } \
        if (tid < 64 * NH) *(LAS float*)(sb + NOFF + tid * 4) = nreg; } while (0)
    ATT_LOAD(0);
    ATT_STORE(0);
    __syncthreads();
    for (int it = 0; it < ntiles; ++it) {
        const bool more = it + 1 < ntiles;
        if (more) ATT_LOAD(it + 1);
        const int key0 = it * 64;
        if (key0 <= qmax) {
            ldsp sb = lds + (it & 1) * STG;
            const LAS bf16_t* sK = (const LAS bf16_t*)(sb + KOFF) + hsel * 64 * AKP;
            const LAS bf16_t* sV = (const LAS bf16_t*)(sb + VOFF) + hsel * 64 * AVP;
            const LAS float* sN = (const LAS float*)(sb + NOFF) + hsel * 64;
            f32x4 S[QT][4];
#pragma unroll
            for (int qt = 0; qt < QT; ++qt)
#pragma unroll
                for (int kg = 0; kg < 4; ++kg) S[qt][kg] = (f32x4){0.f, 0.f, 0.f, 0.f};
#pragma unroll
            for (int ks = 0; ks < 4; ++ks)
#pragma unroll
                for (int kg = 0; kg < 4; ++kg) {
                    const bf16x8 kf = *(const LAS bf16x8*)(sK + (16 * kg + l15) * AKP + 32 * ks + 8 * quad);
#pragma unroll
                    for (int qt = 0; qt < QT; ++qt) S[qt][kg] = mfma16(kf, qf[qt][ks], S[qt][kg]);
                    if (kg == 3) __builtin_amdgcn_sched_barrier(0);
                }
            f32x4 nbv[4];
#pragma unroll
            for (int kg = 0; kg < 4; ++kg) nbv[kg] = *(const LAS f32x4*)(sN + 16 * kg + 4 * quad);
            const bool need_mask = key0 + 63 > qpos_wave;
            bf16x8 pf[QT][2];
#pragma unroll
            for (int qt = 0; qt < QT; ++qt) {
                const int qpos = qpos_wave + 16 * qt + l15;
#pragma unroll
                for (int kg = 0; kg < 4; ++kg) {
                    S[qt][kg] += nbv[kg];
                    if (need_mask) {
#pragma unroll
                        for (int j = 0; j < 4; ++j) if (key0 + 16 * kg + 4 * quad + j > qpos) S[qt][kg][j] = -INFINITY;
                    }
                }
                float mx = -INFINITY;
#pragma unroll
                for (int kg = 0; kg < 4; ++kg)
#pragma unroll
                    for (int j = 0; j < 4; ++j) mx = fmaxf(mx, S[qt][kg][j]);
                mx = fmaxf(mx, __shfl_xor(mx, 16)); mx = fmaxf(mx, __shfl_xor(mx, 32));
                const float mnew = fmaxf(mrow[qt], mx);
                const float alpha = exp2f(mrow[qt] - mnew);
                mrow[qt] = mnew;
                float ps = 0.f;
#pragma unroll
                for (int kg = 0; kg < 4; ++kg)
#pragma unroll
                    for (int j = 0; j < 4; ++j) { const float pv = exp2f(S[qt][kg][j] - mnew); S[qt][kg][j] = pv; ps += pv; }
                lsum[qt] = lsum[qt] * alpha + ps;
#pragma unroll
                for (int dt = 0; dt < 8; ++dt) O[qt][dt] *= alpha;
#pragma unroll
                for (int i = 0; i < 2; ++i) { union { u32x4 u; bf16x8 v; } cv; cv.u = pack8(S[qt][2 * i], S[qt][2 * i + 1]); pf[qt][i] = cv.v; }
                __builtin_amdgcn_sched_barrier(0);
            }
#pragma unroll
            for (int i = 0; i < 2; ++i)
#pragma unroll
                for (int dt = 0; dt < 8; ++dt) {
                    const LAS bf16_t* a0 = sV + (32 * i + 4 * quad + q4) * AVP + 16 * dt + 4 * p4;
                    const bf16x8 vf = trread2(a0, a0 + 16 * AVP);
#pragma unroll
                    for (int qt = 0; qt < QT; ++qt) O[qt][dt] = mfma16(vf, pf[qt][i], O[qt][dt]);
                    if ((dt & 3) == 3) __builtin_amdgcn_sched_barrier(0);
                }
        }
        if (more) ATT_STORE((it + 1) & 1);
        __syncthreads();
    }
#undef ATT_LOAD
#undef ATT_STORE
#pragma unroll
    for (int qt = 0; qt < QT; ++qt) {
        float l = lsum[qt]; l += __shfl_xor(l, 16); l += __shfl_xor(l, 32);
        const float inv = 1.f / l;
#pragma unroll
        for (int dt = 0; dt < 8; ++dt)
            *(u32x2*)(qo + (size_t)(qrow_wave + 16 * qt + l15) * DM + hcol_wave + 16 * dt + 4 * quad) = pack4(O[qt][dt] * inv);
    }
}

__device__ __forceinline__ void attn_phase(ldsp lds, const Params& p) {
    const int w = fresh_tid() >> 6;
    bf16_t* qo = (bf16_t*)(p.ws + WS_QB);
    const bf16_t* kpb = (const bf16_t*)(p.ws + WS_KPB); const bf16_t* vpb = (const bf16_t*)(p.ws + WS_VPB);
    const bf16_t* ksb = (const bf16_t*)(p.ws + WS_KSB); const bf16_t* vsb = (const bf16_t*)(p.ws + WS_VSB);
    const float* nbp = (const float*)(p.ws + WS_NBP); const float* nbs = (const float*)(p.ws + WS_NBS);
    for (int pi = blockIdx.x; pi < 256; pi += gridDim.x) {
        const int h = pi >> 4, pr = pi & 15;
        for (int half = 0; half < 2; ++half) {
            const int qb = half ? pr : 31 - pr;
            attn_item<2, 1>(lds, qo, qb * 256 + 32 * w, qb * 256 + 32 * w, h * 128, 0, kpb + h * 128, vpb + h * 128, nbp + (size_t)h * 8192, nbp + (size_t)h * 8192, 4 * (qb + 1));
        }
    }
    for (int si = blockIdx.x; si < 64; si += gridDim.x) {
        const int b = si >> 3, hp = si & 7;
        const int head = 2 * hp + (w >> 2);
        attn_item<1, 2>(lds, qo, TP + b * 64 + 16 * (w & 3), 2048 + 16 * (w & 3), head * 128, w >> 2,
                        ksb + (size_t)b * 2112 * DM + hp * 256, vsb + (size_t)b * 2112 * DM + hp * 256,
                        nbs + (size_t)(b * 16 + 2 * hp) * 2112, nbs + (size_t)(b * 16 + 2 * hp + 1) * 2112, 33);
    }
}

template <class Epi> __device__ __forceinline__ void run_gemm(ldsp lds, const bf16_t* A, const bf16_t* Bt, int N, int K, const Epi& E) {
    pg8::Gemm g; g.A = A; g.Bt = Bt; g.M = T; g.N = N; g.K = K;
    pg8::StaticOrder S; S.init(T, N, (int)gridDim.x, (int)blockIdx.x);
    pg8::gemm_phase<Epi, pg8::StaticOrder, false>(lds, g, S, E, nullptr);
}

__global__ void __launch_bounds__(512) fwd_megakernel(Params p) {
    extern __shared__ __attribute__((aligned(16))) unsigned char smem[];
    ldsp lds = (ldsp)smem;
    cg::grid_group grid = cg::this_grid();
    unsigned char* ws = p.ws;
    float* ssq = (float*)(ws + WS_SSQ);
    bf16_t* hb = (bf16_t*)(ws + WS_HB);
#ifndef NO_P0
    prep_phase(lds, p);
#endif
    grid.sync();
#ifndef NO_P1
    { Epi1 E; E.ssq = ssq; E.qg = (bf16_t*)(ws + WS_QG); E.kg = (bf16_t*)(ws + WS_KG); E.vg = (bf16_t*)(ws + WS_VG); E.gg = (bf16_t*)(ws + WS_GG); E.gkl = (float*)(ws + WS_GKL);
      run_gemm(lds, hb, (const bf16_t*)(ws + WS_W1), 6400, 2048, E); }
#endif
    grid.sync();
#ifndef NO_P2
    for (int it = blockIdx.x; it < 544; it += gridDim.x) gla_c1(lds, p, it >> 2, it & 3);
#endif
    grid.sync();
#ifndef NO_P3
    gla_c2(p);
#endif
    grid.sync();
#ifndef NO_P4
    for (int it = blockIdx.x; it < 544; it += gridDim.x) gla_c3(lds, p, it >> 2, it & 3);
#endif
    grid.sync();
#ifndef NO_RES
    { EpiRes<false> E; E.res_p = p.x_prompt; E.res_s = p.x_sample; E.y = p.out + O_Y; E.hb = hb; E.ssq_out = ssq + T;
      run_gemm(lds, (const bf16_t*)(ws + WS_OG), (const bf16_t*)(ws + WS_W2), 2048, 2048, E); }
#endif
    grid.sync();
#ifndef NO_GLU
    { EpiGlu E; E.ssq = ssq + T; E.mid = (bf16_t*)(ws + WS_MID); run_gemm(lds, hb, (const bf16_t*)(ws + WS_W3), 11264, 2048, E); }
#endif
    grid.sync();
    { EpiRes<false> E; E.res_p = p.out + O_Y; E.res_s = p.out + O_Y + (size_t)TP * DM; E.y = p.out + O_Y; E.hb = hb; E.ssq_out = ssq + 2 * T;
      run_gemm(lds, (const bf16_t*)(ws + WS_MID), (const bf16_t*)(ws + WS_W4), 2048, 5632, E); }
    grid.sync();
#ifndef NO_KVQ
    { EpiKvq E; E.ssq = ssq + 2 * T; E.out = p.out; E.qb = (bf16_t*)(ws + WS_QB); E.kpb = (bf16_t*)(ws + WS_KPB); E.vpb = (bf16_t*)(ws + WS_VPB);
      E.ksb = (bf16_t*)(ws + WS_KSB); E.vsb = (bf16_t*)(ws + WS_VSB); E.g_k = p.kv_g_k; E.g_q = p.fox_g_q; E.b_f = p.kv_b_f; E.lds = lds;
      run_gemm(lds, hb, (const bf16_t*)(ws + WS_W5), 6400, 2048, E); }
#endif
    grid.sync();
#ifndef NO_P9
    cum_phase(p);
#endif
    grid.sync();
#ifndef NO_ATT
    attn_phase(lds, p);
#endif
    grid.sync();
    { EpiRes<false> E; E.res_p = p.out + O_Y; E.res_s = p.out + O_Y + (size_t)TP * DM; E.y = p.out + O_Y; E.hb = hb; E.ssq_out = ssq + 3 * T;
      run_gemm(lds, (const bf16_t*)(ws + WS_QB), (const bf16_t*)(ws + WS_W6), 2048, 2048, E); }
    grid.sync();
    { EpiGlu E; E.ssq = ssq + 3 * T; E.mid = (bf16_t*)(ws + WS_MID); run_gemm(lds, hb, (const bf16_t*)(ws + WS_W3) + (size_t)11264 * 2048, 11264, 2048, E); }
    grid.sync();
    { EpiRes<true> E; E.res_p = p.out + O_Y; E.res_s = p.out + O_Y + (size_t)TP * DM; E.y = p.out + O_Y; E.hb = hb; E.ssq_out = ssq;
      run_gemm(lds, (const bf16_t*)(ws + WS_MID), (const bf16_t*)(ws + WS_W4) + (size_t)2048 * 5632, 2048, 5632, E); }
}

extern "C" void kernel_launch(void* const* d_in, const int* in_sizes, int n_in, void* d_out, int out_size, void* d_ws, size_t ws_size, hipStream_t stream) {
    static int grid_blocks = 0;
    if (grid_blocks == 0) {
        if (n_in != 22 || ws_size < WS_END) { fprintf(stderr, "kernel_launch: need 22 inputs and %zu bytes of workspace; got %d, %zu\n", (size_t)WS_END, n_in, ws_size); grid_blocks = -1; return; }
        int dev = 0, cus = 0, per_cu = 0;
        hipGetDevice(&dev);
        hipDeviceGetAttribute(&cus, hipDeviceAttributeMultiprocessorCount, dev);
        hipFuncSetAttribute((const void*)fwd_megakernel, hipFuncAttributeMaxDynamicSharedMemorySize, LDS_BYTES);
        hipOccupancyMaxActiveBlocksPerMultiprocessor(&per_cu, (const void*)fwd_megakernel, 512, LDS_BYTES);
        (void)hipGetLastError();
        if (per_cu < 1) per_cu = 1;
        if (per_cu > 1) per_cu = 1;
        grid_blocks = cus * per_cu;
    }
    if (grid_blocks < 0) return;
    Params p{};
    const float** pp = (const float**)&p;
    for (int i = 0; i < 22; ++i) pp[i] = (const float*)d_in[i];
    p.out = (float*)d_out; p.ws = (unsigned char*)d_ws;
    void* args[] = {&p};
    hipError_t e = hipLaunchCooperativeKernel((const void*)fwd_megakernel, dim3(grid_blocks), dim3(512), args, LDS_BYTES, stream);
    if (e != hipSuccess) fprintf(stderr, "cooperative launch failed: %s (grid %d)\n", hipGetErrorString(e), grid_blocks);
}
```

```cpp
#include <hip/hip_runtime.h>
#include <hip/hip_cooperative_groups.h>
#include <cstdio>
namespace cg = cooperative_groups;
namespace pg8 {
#define PG8_LAS __attribute__((address_space(3)))
typedef unsigned short bf16_t;
typedef short bf16x8 __attribute__((ext_vector_type(8)));
typedef float f32x4 __attribute__((ext_vector_type(4)));
typedef unsigned u32x4 __attribute__((ext_vector_type(4)));
constexpr int BM = 256, BK = 64, HALF = 128, HTB = HALF * BK * 2  , STAGE_BYTES = 8 * HTB, NXCD = 8, WGM = 8;

__host__ __device__ __forceinline__ int lds_byte(int r, int c) { const int st = (r >> 4) * 2 + (c >> 5), rr = r & 15, cc = c & 31, ob = rr * 64 + cc * 2; return st * 1024 + (ob ^ (((ob >> 9) & 1) << 5)); }
__host__ __device__ __forceinline__ void stage_rc(int b, int& R, int& C) { const int st = b / 1024, sb = b % 1024, swz = sb ^ (((sb >> 9) & 1) << 5); R = (st >> 1) * 16 + swz / 64; C = (st & 1) * 32 + (swz % 64) / 2; }
__host__ __device__ __forceinline__ int perm32(int rho) { const int n = rho >> 4, i = rho & 15; return 8 * (i >> 2) + 4 * n + (i & 3); }

struct Unit { int pm, pn; };
struct Gemm { const bf16_t* A; const bf16_t* Bt; int M, N, K; };

struct StaticOrder {
    int nM, nN, nwg, G, c;
    __host__ __device__ void init(int M, int N, int G_, int c_) { nM = M / BM; nN = N / BM; nwg = nM * nN; G = G_; c = c_; }
    __host__ __device__ bool next(int i, Unit& u) const {
        const long L = (long)i * G + c; if (L >= nwg) return false;
        int wgid = (int)L; { const int q = nwg / NXCD, r = nwg % NXCD, xcd = wgid % NXCD, off = wgid / NXCD; wgid = (xcd < r ? xcd * (q + 1) : r * (q + 1) + (xcd - r) * q) + off; }
        const int nig = WGM * nN, gid = wgid / nig, fm = gid * WGM, gsz = (nM - fm) < WGM ? (nM - fm) : WGM;
        u.pm = fm + ((wgid % nig) % gsz); u.pn = (wgid % nig) / gsz; return true;
    }
    __device__ __forceinline__ void a_ready(const Unit&) const {}
    __device__ __forceinline__ void done(const Unit&) const {}
};
__device__ __forceinline__ unsigned cvt_pk_bf16(float lo, float hi) { unsigned r; asm volatile("v_cvt_pk_bf16_f32 %0, %1, %2" : "=v"(r) : "v"(lo), "v"(hi)); return r; }
template <class Epi, class Sched, bool STAMP = false>
__device__ __forceinline__ void gemm_phase(PG8_LAS unsigned char* lds, const Gemm g, const Sched& S, const Epi& E, unsigned long long* stamps) {
    int tid_ = threadIdx.x; asm volatile("" : "+v"(tid_)); const int tid = tid_, wid = __builtin_amdgcn_readfirstlane(tid >> 6), lane = tid & 63, wr = wid >> 2, wc = wid & 3, fr = lane & 15, fq = lane >> 4;
    const int K = g.K, nt = K / BK;
    int ts_lo = 0, ts_hi = 0, nts = 0; const unsigned long long rt_entry = STAMP ? (unsigned long long)wall_clock64() : 0ull;
#define PG8_STAMP() do { if (STAMP && wid == 0 && nts < 64) { const unsigned long long _c = (unsigned long long)clock64(); \
        ts_lo = (lane == nts) ? (int)(unsigned)_c : ts_lo; ts_hi = (lane == nts) ? (int)(unsigned)(_c >> 32) : ts_hi; ++nts; } } while (0)
    PG8_STAMP();
    unsigned voffA[2], voffB[2];
#pragma unroll
    for (int i = 0; i < 2; ++i) { int R, C; stage_rc(tid * 16 + i * 8192, R, C); const int Rb = Epi::PERM ? ((R & ~31) + perm32(R & 31)) : R;
        voffA[i] = (unsigned)(R * K + C) * 2u; voffB[i] = (unsigned)(Rb * K + C) * 2u; }
    const size_t kstep = (size_t)(BK * 2);
    const size_t hstep = (size_t)HALF * K * 2;
    const size_t tstep = 2 * hstep;
    const unsigned ldsw = (unsigned)wid * 1024u;
    const int aoff = lds_byte(wr * 64 + fr, fq * 8), boff = lds_byte(wc * 32 + fr, fq * 8);
#define PG8_SA(b, h) (((b) * 2 + (h)) * HTB)
#define PG8_SB(b, h) ((4 + (b) * 2 + (h)) * HTB)
#define PG8_STAGE(bufoff, gbase, voff) do { _Pragma("unroll") for (int _i = 0; _i < 2; ++_i) \
        __builtin_amdgcn_global_load_lds((const unsigned*)((const char*)(gbase) + (voff)[_i]), (PG8_LAS unsigned*)(lds + (bufoff) + ldsw + _i * 8192), 16, 0, 0); } while (0)
#define PG8_LDA(dst, b, h) do { _Pragma("unroll") for (int m = 0; m < 4; ++m) _Pragma("unroll") for (int k = 0; k < 2; ++k) dst[m][k] = *(const PG8_LAS bf16x8*)(lds + PG8_SA(b, h) + aoff + m * 2048 + k * 1024); } while (0)
#define PG8_LDB(dst, b, h) do { _Pragma("unroll") for (int n = 0; n < 2; ++n) _Pragma("unroll") for (int k = 0; k < 2; ++k) dst[n][k] = *(const PG8_LAS bf16x8*)(lds + PG8_SB(b, h) + boff + n * 2048 + k * 1024); } while (0)
#define PG8_MMA(ai, bj, At, Bt) do { __builtin_amdgcn_s_setprio(1); _Pragma("unroll") for (int m = 0; m < 4; ++m) _Pragma("unroll") for (int n = 0; n < 2; ++n) _Pragma("unroll") for (int k = 0; k < 2; ++k) \
        acc[ai][bj][m][n] = __builtin_amdgcn_mfma_f32_16x16x32_bf16(Bt[n][k], At[m][k], acc[ai][bj][m][n], 0, 0, 0); __builtin_amdgcn_s_setprio(0); } while (0)
#define PG8_WAIT_V(n) asm volatile("s_waitcnt vmcnt(" #n ")" ::: "memory")
#define PG8_WAIT_L(n) asm volatile("s_waitcnt lgkmcnt(" #n ")" ::: "memory")
#define PG8_BAR __builtin_amdgcn_s_barrier()
#define PG8_SCHED __builtin_amdgcn_sched_barrier(0)
    Unit cur, nxt; int ui = 0;
    if (!S.next(0, cur)) return;
    f32x4 acc[2][2][4][2];
#pragma unroll
    for (int a = 0; a < 2; ++a)
#pragma unroll
        for (int b = 0; b < 2; ++b)
#pragma unroll
            for (int m = 0; m < 4; ++m)
#pragma unroll
                for (int n = 0; n < 2; ++n) acc[a][b][m][n] = (f32x4){0.f, 0.f, 0.f, 0.f};
    bf16x8 At[4][2], B0[2][2], B1[2][2];
    const char* cA = (const char*)g.A + (size_t)cur.pm * tstep; const char* cB = (const char*)g.Bt + (size_t)cur.pn * tstep;
    S.a_ready(cur);
    PG8_STAGE(PG8_SB(0, 0), cB, voffB); PG8_STAGE(PG8_SA(0, 0), cA, voffA); PG8_STAGE(PG8_SB(0, 1), cB + hstep, voffB); PG8_STAGE(PG8_SA(0, 1), cA + hstep, voffA);
    if (wr == 1) PG8_BAR;
    PG8_WAIT_V(4); PG8_BAR;
    PG8_STAGE(PG8_SB(1, 0), cB + kstep, voffB); PG8_STAGE(PG8_SA(1, 0), cA + kstep, voffA); PG8_STAGE(PG8_SB(1, 1), cB + hstep + kstep, voffB);
    PG8_WAIT_V(6); PG8_BAR;
    PG8_STAMP();
    for (;;) {
        const bool has_next = S.next(ui + 1, nxt);
        const char* nA = has_next ? (const char*)g.A + (size_t)nxt.pm * tstep : cA; const char* nB = has_next ? (const char*)g.Bt + (size_t)nxt.pn * tstep : cB;
        for (int t = 0; t < nt; t += 2) {
            const bool last = (t == nt - 2);
            const char* a1 = cA + (size_t)(t + 1) * kstep;
            const char* a2 = last ? nA : cA + (size_t)(t + 2) * kstep; const char* b2 = last ? nB : cB + (size_t)(t + 2) * kstep;
            const char* a3 = a2 + kstep; const char* b3 = b2 + kstep;
            if (last && has_next) S.a_ready(nxt);
            PG8_LDB(B0, 0, 0); PG8_SCHED; PG8_LDA(At, 0, 0); PG8_STAGE(PG8_SA(1, 1), a1 + hstep, voffA);
            PG8_WAIT_L(8); PG8_BAR; PG8_WAIT_L(0); PG8_MMA(0, 0, At, B0); PG8_BAR; PG8_SCHED;
            PG8_LDB(B1, 0, 1); PG8_STAGE(PG8_SB(0, 0), b2, voffB);
            PG8_BAR; PG8_WAIT_L(0); PG8_MMA(0, 1, At, B1); PG8_BAR;
            PG8_LDA(At, 0, 1); PG8_STAGE(PG8_SA(0, 0), a2, voffA);
            PG8_BAR; PG8_WAIT_L(0); PG8_MMA(1, 0, At, B0); PG8_BAR; PG8_SCHED;
            PG8_STAGE(PG8_SB(0, 1), b2 + hstep, voffB);
            PG8_WAIT_V(6); PG8_BAR; PG8_MMA(1, 1, At, B1); PG8_BAR;
            PG8_LDB(B0, 1, 0); PG8_SCHED; PG8_LDA(At, 1, 0); PG8_STAGE(PG8_SA(0, 1), a2 + hstep, voffA);
            PG8_WAIT_L(8); PG8_BAR; PG8_WAIT_L(0); PG8_MMA(0, 0, At, B0); PG8_BAR; PG8_SCHED;
            PG8_LDB(B1, 1, 1); PG8_STAGE(PG8_SB(1, 0), b3, voffB);
            PG8_BAR; PG8_WAIT_L(0); PG8_MMA(0, 1, At, B1); PG8_BAR;
            PG8_LDA(At, 1, 1); PG8_STAGE(PG8_SA(1, 0), a3, voffA);
            PG8_BAR; PG8_WAIT_L(0); PG8_MMA(1, 0, At, B0); PG8_BAR; PG8_SCHED;
            PG8_STAGE(PG8_SB(1, 1), b3 + hstep, voffB);
            PG8_WAIT_V(6); PG8_BAR; PG8_MMA(1, 1, At, B1); PG8_BAR;
        }
        PG8_STAMP();
        if constexpr (!Epi::AFTER_DRAIN) { E(acc, cur, wr, wc, fr, fq); S.done(cur); }
        PG8_STAMP();
        if (!has_next) break;
#pragma unroll
        for (int a = 0; a < 2; ++a)
#pragma unroll
            for (int b = 0; b < 2; ++b)
#pragma unroll
                for (int m = 0; m < 4; ++m)
#pragma unroll
                    for (int n = 0; n < 2; ++n) acc[a][b][m][n] = (f32x4){0.f, 0.f, 0.f, 0.f};
        cur = nxt; cA = nA; cB = nB; ++ui;
    }
    PG8_WAIT_V(0);
    if (wr == 0) PG8_BAR;
    PG8_BAR;
    if constexpr (Epi::AFTER_DRAIN) { E.fused(acc, cur, wr, wc, fr, fq, lds, wid, lane); S.done(cur); }
    PG8_STAMP();
    if (STAMP && wid == 0) { stamps[lane] = lane < nts ? (((unsigned long long)(unsigned)ts_hi << 32) | (unsigned)ts_lo) : 0ull;
        if (lane == 62) stamps[62] = rt_entry; if (lane == 63) stamps[63] = (unsigned long long)wall_clock64(); }
#undef PG8_STAMP
#undef PG8_SA
#undef PG8_SB
#undef PG8_STAGE
#undef PG8_LDA
#undef PG8_LDB
#undef PG8_MMA
#undef PG8_WAIT_V
#undef PG8_WAIT_L
#undef PG8_BAR
#undef PG8_SCHED
}
}

using pg8::bf16_t; using pg8::bf16x8; using pg8::f32x4; using pg8::u32x4; using pg8::Unit; using pg8::cvt_pk_bf16;
#define LAS __attribute__((address_space(3)))
typedef short s16x4 __attribute__((ext_vector_type(4)));
typedef unsigned u32x2 __attribute__((ext_vector_type(2)));
typedef LAS unsigned char* ldsp;

constexpr int T = 8704, TP = 8192, DM = 2048, DFF = 5632;
constexpr float EPS = 1e-6f;
constexpr float LOG2E = 1.4426950408889634f;
constexpr float QSCALE = 0.08838834764831845f * LOG2E;

constexpr size_t O_Y = 0, O_SGP = 17825792, O_KP = 18350080, O_VP = 35127296, O_LFP = 51904512, O_SGS = 52035584,
                 O_KS = 56229888, O_VS = 57278464, O_LFS = 58327040;

constexpr size_t al256(size_t x) { return (x + 255) & ~(size_t)255; }
constexpr size_t WS_W1 = 0;
constexpr size_t WS_W2 = WS_W1 + (size_t)6400 * 2048 * 2;
constexpr size_t WS_W3 = WS_W2 + (size_t)2048 * 2048 * 2;
constexpr size_t WS_W4 = WS_W3 + 2 * (size_t)11264 * 2048 * 2;
constexpr size_t WS_W5 = WS_W4 + 2 * (size_t)2048 * 5632 * 2;
constexpr size_t WS_W6 = WS_W5 + (size_t)6400 * 2048 * 2;
constexpr size_t WS_HB = WS_W6 + (size_t)2048 * 2048 * 2;
constexpr size_t WS_SSQ = WS_HB + (size_t)T * 2048 * 2;
constexpr size_t WS_NBP = al256(WS_SSQ + 4 * (size_t)T * 4);
constexpr size_t WS_NBS = WS_NBP + (size_t)16 * 8192 * 4;
constexpr size_t WS_R = al256(WS_NBS + (size_t)128 * 2112 * 4);
constexpr size_t WS_QG = WS_R;
constexpr size_t WS_KG = WS_QG + (size_t)T * 1024 * 2;
constexpr size_t WS_VG = WS_KG + (size_t)T * 1024 * 2;
constexpr size_t WS_GG = WS_VG + (size_t)T * 2048 * 2;
constexpr size_t WS_GKL = WS_GG + (size_t)T * 2048 * 2;
constexpr size_t WS_QT = WS_GKL + (size_t)T * 16 * 4;
constexpr size_t WS_ATT = WS_QT + (size_t)T * 1024 * 2;
constexpr size_t WS_DEC = WS_ATT + (size_t)136 * 4 * 64 * 64 * 2;
constexpr size_t WS_DS = WS_DEC + (size_t)136 * 4 * 256 * 4;
constexpr size_t WS_OG = WS_DS + (size_t)128 * 4 * 512 * 256 * 2;
constexpr size_t WS_GLA_END = WS_OG + (size_t)T * 2048 * 2;
constexpr size_t WS_MID = WS_R;
constexpr size_t WS_QB = WS_MID + (size_t)T * 5632 * 2;
constexpr size_t WS_KPB = WS_QB + (size_t)T * 2048 * 2;
constexpr size_t WS_VPB = WS_KPB + (size_t)8192 * 2048 * 2;
constexpr size_t WS_KSB = WS_VPB + (size_t)8192 * 2048 * 2;
constexpr size_t WS_VSB = WS_KSB + (size_t)8 * 2112 * 2048 * 2;
constexpr size_t WS_AO = WS_VSB + (size_t)8 * 2112 * 2048 * 2;
constexpr size_t WS_LATE_END = WS_AO + (size_t)T * 2048 * 2;
constexpr size_t WS_END = WS_LATE_END > WS_GLA_END ? WS_LATE_END : WS_GLA_END;

constexpr int LDS_BYTES = 147456;
constexpr int XCH_OFF = 131072;

struct Params {
    const float *x_prompt, *x_sample, *state_gla, *cache_k, *cache_v, *cache_logf, *g_mix, *g_ffn, *gla_w_in, *gla_w_gk2, *gla_b_gk,
        *gla_g_out, *gla_w_out, *kv_g, *kv_w, *kv_b_f, *kv_g_k, *fox_w_q, *fox_g_q, *fox_w_o, *ffn_w_in, *ffn_w_out;
    float* out; unsigned char* ws;
};

__device__ __forceinline__ int fresh_tid() { int t = threadIdx.x; asm volatile("" : "+v"(t)); return t; }
__device__ __forceinline__ float bf2f(unsigned x) { return __uint_as_float(x << 16); }
__device__ __forceinline__ bf16_t f2bf(float x) { return (bf16_t)(cvt_pk_bf16(x, 0.f) & 0xffffu); }
__device__ __forceinline__ float logsig(float z) { return fminf(z, 0.f) - log1pf(__expf(-fabsf(z))); }
__device__ __forceinline__ float silu(float g) { return g / (1.f + __expf(-g)); }
__device__ __forceinline__ bf16x8 trread2(const LAS bf16_t* p0, const LAS bf16_t* p1) {
    s16x4 a = __builtin_amdgcn_ds_read_tr16_b64_v4i16((LAS s16x4*)p0);
    s16x4 b = __builtin_amdgcn_ds_read_tr16_b64_v4i16((LAS s16x4*)p1);
    bf16x8 r; r[0] = a[0]; r[1] = a[1]; r[2] = a[2]; r[3] = a[3]; r[4] = b[0]; r[5] = b[1]; r[6] = b[2]; r[7] = b[3]; return r;
}
__device__ __forceinline__ f32x4 mfma16(bf16x8 a, bf16x8 b, f32x4 c) { return __builtin_amdgcn_mfma_f32_16x16x32_bf16(a, b, c, 0, 0, 0); }
__device__ __forceinline__ u32x2 pack4(f32x4 v) { u32x2 r; r.x = cvt_pk_bf16(v[0], v[1]); r.y = cvt_pk_bf16(v[2], v[3]); return r; }
__device__ __forceinline__ u32x4 pack8(f32x4 a, f32x4 b) { u32x4 r; r.x = cvt_pk_bf16(a[0], a[1]); r.y = cvt_pk_bf16(a[2], a[3]); r.z = cvt_pk_bf16(b[0], b[1]); r.w = cvt_pk_bf16(b[2], b[3]); return r; }

struct Epi1 {
    static constexpr bool PERM = true, AFTER_DRAIN = false;
    const float* ssq; bf16_t *qg, *kg, *vg, *gg; float* gkl;
    __device__ __forceinline__ void operator()(const f32x4 (&acc)[2][2][4][2], const Unit& u, int wr, int wc, int fr, int fq) const {
        const int pn = u.pn;
        bf16_t* base; int ld, cb; float sc = 1.f;
        if (pn < 4) { base = qg; ld = 1024; cb = pn * 256; sc = 0.0625f; }
        else if (pn < 8) { base = kg; ld = 1024; cb = (pn - 4) * 256; }
        else if (pn < 16) { base = vg; ld = 2048; cb = (pn - 8) * 256; }
        else { base = gg; ld = 2048; cb = (pn - 16) * 256; }
#pragma unroll
        for (int ai = 0; ai < 2; ++ai)
#pragma unroll
            for (int m = 0; m < 4; ++m) {
                const int row = u.pm * 256 + ai * 128 + wr * 64 + m * 16 + fr;
                const float rs = rsqrtf(ssq[row] * (1.f / 2048.f) + EPS) * sc;
                if (pn < 24) {
#pragma unroll
                    for (int bj = 0; bj < 2; ++bj) {
                        const int col = cb + bj * 128 + wc * 32 + fq * 8;
                        *(u32x4*)(base + (size_t)row * ld + col) = pack8(acc[ai][bj][m][0] * rs, acc[ai][bj][m][1] * rs);
                    }
                } else if (wc == 0 && fq < 2) {
                    float* gp = gkl + (size_t)row * 16 + fq * 8;
                    *(f32x4*)gp = acc[ai][0][m][0] * rs; *(f32x4*)(gp + 4) = acc[ai][0][m][1] * rs;
                }
            }
    }
};

template <bool LAST> struct EpiRes {
    static constexpr bool PERM = true, AFTER_DRAIN = false;
    const float *res_p, *res_s; float* y; bf16_t* hb; float* ssq_out;
    __device__ __forceinline__ void operator()(const f32x4 (&acc)[2][2][4][2], const Unit& u, int wr, int wc, int fr, int fq) const {
#pragma unroll
        for (int ai = 0; ai < 2; ++ai)
#pragma unroll
            for (int m = 0; m < 4; ++m) {
                const int row = u.pm * 256 + ai * 128 + wr * 64 + m * 16 + fr;
                const float* rp = row < TP ? res_p + (size_t)row * DM : res_s + (size_t)(row - TP) * DM;
                float ss = 0.f;
#pragma unroll
                for (int bj = 0; bj < 2; ++bj) {
                    const int col = u.pn * 256 + bj * 128 + wc * 32 + fq * 8;
                    const f32x4 v0 = acc[ai][bj][m][0] + *(const f32x4*)(rp + col), v1 = acc[ai][bj][m][1] + *(const f32x4*)(rp + col + 4);
                    float* yp = y + (size_t)row * DM + col;
                    *(f32x4*)yp = v0; *(f32x4*)(yp + 4) = v1;
                    if (!LAST) {
                        *(u32x4*)(hb + (size_t)row * DM + col) = pack8(v0, v1);
                        ss += v0[0] * v0[0] + v0[1] * v0[1] + v0[2] * v0[2] + v0[3] * v0[3] + v1[0] * v1[0] + v1[1] * v1[1] + v1[2] * v1[2] + v1[3] * v1[3];
                    }
                }
                if (!LAST) {
                    ss += __shfl_xor(ss, 16); ss += __shfl_xor(ss, 32);
                    if (fq == 0) atomicAdd(ssq_out + row, ss);
                }
            }
    }
};

struct EpiGlu {
    static constexpr bool PERM = true, AFTER_DRAIN = false;
    const float* ssq; bf16_t* mid;
    __device__ __forceinline__ void operator()(const f32x4 (&acc)[2][2][4][2], const Unit& u, int wr, int wc, int fr, int fq) const {
#pragma unroll
        for (int ai = 0; ai < 2; ++ai)
#pragma unroll
            for (int m = 0; m < 4; ++m) {
                const int row = u.pm * 256 + ai * 128 + wr * 64 + m * 16 + fr;
                const float rs = rsqrtf(ssq[row] * (1.f / 2048.f) + EPS);
#pragma unroll
                for (int bj = 0; bj < 2; ++bj) {
                    const f32x4 g = acc[ai][bj][m][0] * rs, up = acc[ai][bj][m][1] * rs;
                    f32x4 o;
#pragma unroll
                    for (int i = 0; i < 4; ++i) o[i] = silu(g[i]) * up[i];
                    const int col = u.pn * 128 + bj * 64 + wc * 16 + fq * 4;
                    *(u32x2*)(mid + (size_t)row * DFF + col) = pack4(o);
                }
            }
    }
};

struct EpiKvq {
    static constexpr bool PERM = true, AFTER_DRAIN = false;
    const float* ssq; float* out; bf16_t *qb, *kpb, *vpb, *ksb, *vsb; const float *g_k, *g_q, *b_f; ldsp lds;
    __device__ __forceinline__ void operator()(const f32x4 (&acc)[2][2][4][2], const Unit& u, int wr, int wc, int fr, int fq) const {
        const int pn = u.pn;
        LAS float* xch = (LAS float*)(lds + XCH_OFF);
        const bool normed = (pn < 8) || (pn >= 16 && pn < 24);
        if (normed) {
#pragma unroll
            for (int ai = 0; ai < 2; ++ai)
#pragma unroll
                for (int m = 0; m < 4; ++m) {
                    const int rl = ai * 128 + wr * 64 + m * 16 + fr;
#pragma unroll
                    for (int bj = 0; bj < 2; ++bj) {
                        const f32x4 a = acc[ai][bj][m][0], b = acc[ai][bj][m][1];
                        float s = a[0] * a[0] + a[1] * a[1] + a[2] * a[2] + a[3] * a[3] + b[0] * b[0] + b[1] * b[1] + b[2] * b[2] + b[3] * b[3];
                        s += __shfl_xor(s, 16); s += __shfl_xor(s, 32);
                        if (fq == 0) xch[rl * 8 + bj * 4 + wc] = s;
                    }
                }
            asm volatile("s_waitcnt lgkmcnt(0)" ::: "memory");
            __builtin_amdgcn_s_barrier();
            asm volatile("" ::: "memory");
        }
#pragma unroll
        for (int ai = 0; ai < 2; ++ai)
#pragma unroll
            for (int m = 0; m < 4; ++m) {
                const int rl = ai * 128 + wr * 64 + m * 16 + fr;
                const int row = u.pm * 256 + rl;
                const float rs = rsqrtf(ssq[row] * (1.f / 2048.f) + EPS);
                const bool prm = row < TP;
                const int sr = row - TP;
                if (normed) {
                    const f32x4 x0 = *(const LAS f32x4*)(xch + rl * 8), x1 = *(const LAS f32x4*)(xch + rl * 8 + 4);
                    const float hs0 = (x0[0] + x0[1] + x0[2] + x0[3]) * rs * rs, hs1 = (x1[0] + x1[1] + x1[2] + x1[3]) * rs * rs;
                    const bool isq = pn >= 16;
                    const float* gv = isq ? g_q : g_k;
                    const f32x4 g0 = *(const f32x4*)(gv + wc * 32 + fq * 8), g1 = *(const f32x4*)(gv + wc * 32 + fq * 8 + 4);
#pragma unroll
                    for (int bj = 0; bj < 2; ++bj) {
                        const float hr = rsqrtf((bj ? hs1 : hs0) * (1.f / 128.f) + EPS) * rs * (isq ? QSCALE : 1.f);
                        const f32x4 v0 = acc[ai][bj][m][0] * hr * g0, v1 = acc[ai][bj][m][1] * hr * g1;
                        if (isq) {
                            const int col = (pn - 16) * 256 + bj * 128 + wc * 32 + fq * 8;
                            *(u32x4*)(qb + (size_t)row * DM + col) = pack8(v0, v1);
                        } else {
                            const int col = pn * 256 + bj * 128 + wc * 32 + fq * 8;
                            float* op = prm ? out + O_KP + (size_t)row * DM + col : out + O_KS + (size_t)sr * DM + col;
                            *(f32x4*)op = v0; *(f32x4*)(op + 4) = v1;
                            bf16_t* bp = prm ? kpb + (size_t)row * DM + col : ksb + ((size_t)(sr >> 6) * 2112 + 2048 + (sr & 63)) * DM + col;
                            *(u32x4*)bp = pack8(v0, v1);
                        }
                    }
                } else if (pn < 16) {
#pragma unroll
                    for (int bj = 0; bj < 2; ++bj) {
                        const f32x4 v0 = acc[ai][bj][m][0] * rs, v1 = acc[ai][bj][m][1] * rs;
                        const int col = (pn - 8) * 256 + bj * 128 + wc * 32 + fq * 8;
                        float* op = prm ? out + O_VP + (size_t)row * DM + col : out + O_VS + (size_t)sr * DM + col;
                        *(f32x4*)op = v0; *(f32x4*)(op + 4) = v1;
                        bf16_t* bp = prm ? vpb + (size_t)row * DM + col : vsb + ((size_t)(sr >> 6) * 2112 + 2048 + (sr & 63)) * DM + col;
                        *(u32x4*)bp = pack8(v0, v1);
                    }
                } else if (wc == 0 && fq < 2) {
                    float* op = prm ? out + O_LFP + (size_t)row * 16 + fq * 8 : out + O_LFS + (size_t)sr * 16 + fq * 8;
                    f32x4 v0 = acc[ai][0][m][0] * rs, v1 = acc[ai][0][m][1] * rs;
                    const f32x4 b0 = *(const f32x4*)(b_f + fq * 8), b1 = *(const f32x4*)(b_f + fq * 8 + 4);
#pragma unroll
                    for (int i = 0; i < 4; ++i) { v0[i] = logsig(v0[i] + b0[i]); v1[i] = logsig(v1[i] + b1[i]); }
                    *(f32x4*)op = v0; *(f32x4*)(op + 4) = v1;
                }
                __builtin_amdgcn_sched_barrier(0);
            }
    }
};

__device__ __forceinline__ void prep_phase(ldsp lds, const Params& p) {
    const int tid = fresh_tid(), lane = tid & 63, w = tid >> 6;
    LAS bf16_t* tile = (LAS bf16_t*)lds;
    for (int tix = blockIdx.x; tix < 25344; tix += gridDim.x) {
        int mat, lt;
        if (tix < 3200) { mat = 0; lt = tix; } else if (tix < 4224) { mat = 1; lt = tix - 3200; } else if (tix < 9856) { mat = 2; lt = tix - 4224; }
        else if (tix < 15488) { mat = 3; lt = tix - 9856; } else if (tix < 18304) { mat = 4; lt = tix - 15488; } else if (tix < 21120) { mat = 5; lt = tix - 18304; }
        else if (tix < 24320) { mat = 6; lt = tix - 21120; } else { mat = 7; lt = tix - 24320; }
        const int K = (mat == 4 || mat == 5) ? 5632 : 2048;
        const int nkt = K / 64;
        const int nt = lt / nkt, kt = lt - nt * nkt;
        const int n0 = nt * 64, k0 = kt * 64;
        const float* src; int ld; const float* g = nullptr; bf16_t* dst;
        const int n4 = (tid & 15) * 4;
        const int n = n0 + n4;
        int col;
        switch (mat) {
            case 0: src = p.gla_w_in; ld = 6160; g = p.g_mix; dst = (bf16_t*)(p.ws + WS_W1); col = n < 6160 ? n : -1; break;
            case 1: src = p.gla_w_out; ld = 2048; dst = (bf16_t*)(p.ws + WS_W2); col = n; break;
            case 2: case 3: { const int l = mat - 2; src = p.ffn_w_in + (size_t)l * 2048 * 11264; ld = 11264; g = p.g_ffn + l * 2048; dst = (bf16_t*)(p.ws + WS_W3) + (size_t)l * 11264 * 2048;
                      col = ((n >> 2) & 1) * 5632 + 4 * (n >> 3) + (n & 3); break; }
            case 4: case 5: { const int l = mat - 4; src = p.ffn_w_out + (size_t)l * 5632 * 2048; ld = 2048; dst = (bf16_t*)(p.ws + WS_W4) + (size_t)l * 2048 * 5632; col = n; break; }
            case 6: dst = (bf16_t*)(p.ws + WS_W5);
                    if (n < 4096) { src = p.kv_w; ld = 4112; g = p.kv_g; col = n; }
                    else if (n < 6144) { src = p.fox_w_q; ld = 2048; g = p.g_mix + 2048; col = n - 4096; }
                    else { src = p.kv_w; ld = 4112; g = p.kv_g; col = n < 6160 ? 4096 + (n - 6144) : -1; }
                    break;
            default: src = p.fox_w_o; ld = 2048; dst = (bf16_t*)(p.ws + WS_W6); col = n; break;
        }
        f32x4 v[2];
        const int kk = tid >> 4;
#pragma unroll
        for (int i = 0; i < 2; ++i) {
            const int k = k0 + kk + 32 * i;
            f32x4 x = {0.f, 0.f, 0.f, 0.f};
            if (col >= 0) x = *(const f32x4*)(src + (size_t)k * ld + col);
            if (g) x *= g[k];
            v[i] = x;
        }
#pragma unroll
        for (int i = 0; i < 2; ++i)
#pragma unroll
            for (int j = 0; j < 4; ++j) tile[(n4 + j) * 66 + kk + 32 * i] = f2bf(v[i][j]);
        __syncthreads();
        {
            const int nn = tid >> 3, kc = (tid & 7) * 8;
            const LAS unsigned* sp = (const LAS unsigned*)(tile + nn * 66 + kc);
            u32x4 o; o.x = sp[0]; o.y = sp[1]; o.z = sp[2]; o.w = sp[3];
            *(u32x4*)(dst + (size_t)(n0 + nn) * K + k0 + kc) = o;
        }
        __syncthreads();
    }
    bf16_t* hb = (bf16_t*)(p.ws + WS_HB);
    float* ssq = (float*)(p.ws + WS_SSQ);
    for (int rb = blockIdx.x; rb < T / 8; rb += gridDim.x) {
        const int row = rb * 8 + w;
        const float* src = row < TP ? p.x_prompt + (size_t)row * DM : p.x_sample + (size_t)(row - TP) * DM;
        float ss = 0.f;
#pragma unroll
        for (int i = 0; i < 8; ++i) {
            const f32x4 x = *(const f32x4*)(src + (i * 64 + lane) * 4);
            ss += x[0] * x[0] + x[1] * x[1] + x[2] * x[2] + x[3] * x[3];
            *(u32x2*)(hb + (size_t)row * DM + (i * 64 + lane) * 4) = pack4(x);
        }
#pragma unroll
        for (int o = 32; o >= 1; o >>= 1) ss += __shfl_xor(ss, o);
        if (lane == 0) ssq[row] = ss;
    }
    for (int i = blockIdx.x * 512 + tid; i < 3 * T; i += gridDim.x * 512) ssq[T + i] = 0.f;
}

constexpr int QP = 264, VPI = 528, KDP = 72;
__device__ __forceinline__ void gla_c1(ldsp lds, const Params& p, int ci, int h) {
    const int tid = fresh_tid(), lane = tid & 63, w = tid >> 6, quad = lane >> 4, l15 = lane & 15;
    const int r0 = ci < 128 ? ci * 64 : TP + (ci - 128) * 64;
    LAS bf16_t* sQ = (LAS bf16_t*)lds;
    LAS bf16_t* sK = sQ + 64 * QP;
    LAS bf16_t* sV = (LAS bf16_t*)lds;
    LAS bf16_t* sKd = (LAS bf16_t*)(lds + 67584);
    LAS float* sG = (LAS float*)(lds + 67584 + 36864);
    LAS float* sH = sG + 1024;
    LAS float* sDec = sH + 512;
    const bf16_t* qg = (const bf16_t*)(p.ws + WS_QG); const bf16_t* kg = (const bf16_t*)(p.ws + WS_KG); const bf16_t* vg = (const bf16_t*)(p.ws + WS_VG);
    const float* gkl = (const float*)(p.ws + WS_GKL);
    bf16_t* qt = (bf16_t*)(p.ws + WS_QT); bf16_t* attb = (bf16_t*)(p.ws + WS_ATT); float* dec = (float*)(p.ws + WS_DEC); bf16_t* dsb = (bf16_t*)(p.ws + WS_DS);
    if (tid < 256) *(LAS f32x4*)(sG + tid * 4) = *(const f32x4*)(gkl + (size_t)(r0 + (tid >> 2)) * 16 + (tid & 3) * 4);
    __syncthreads();
    const int d = tid & 255, hf = tid >> 8;
    float bv[32];
    {
        float w2[16];
#pragma unroll
        for (int r = 0; r < 16; ++r) w2[r] = p.gla_w_gk2[r * 1024 + h * 256 + d];
        const float bias = p.gla_b_gk[h * 256 + d];
        float run = 0.f;
#pragma unroll
        for (int i = 0; i < 32; ++i) {
            const int t = hf * 32 + i;
            float z = bias;
#pragma unroll
            for (int r4 = 0; r4 < 4; ++r4) { const f32x4 gq = *(const LAS f32x4*)(sG + t * 16 + r4 * 4); z += gq[0] * w2[r4 * 4] + gq[1] * w2[r4 * 4 + 1] + gq[2] * w2[r4 * 4 + 2] + gq[3] * w2[r4 * 4 + 3]; }
            run += logsig(z) * 0.0625f;
            bv[i] = run;
        }
        sH[hf * 256 + d] = run;
    }
    __syncthreads();
    const float h0 = sH[d], h1 = sH[256 + d];
    const float blast = h0 + h1, boff = hf ? h0 : 0.f;
    if (hf == 0) { const float dv = __expf(blast); sDec[d] = dv; dec[(size_t)(ci * 4 + h) * 256 + d] = dv; }
#pragma unroll
    for (int i8 = 0; i8 < 4; ++i8) {
        float kd[8];
#pragma unroll
        for (int j = 0; j < 8; ++j) {
            const int i = i8 * 8 + j, t = hf * 32 + i;
            const float b = bv[i] + boff;
            const float qv = bf2f(qg[(size_t)(r0 + t) * 1024 + h * 256 + d]), kv = bf2f(kg[(size_t)(r0 + t) * 1024 + h * 256 + d]);
            const bf16_t qs = f2bf(qv * __expf(b));
            sQ[t * QP + d] = qs; qt[(size_t)(r0 + t) * 1024 + h * 256 + d] = qs;
            sK[t * QP + d] = f2bf(kv * __expf(-b));
            kd[j] = kv * __expf(blast - b);
        }
        u32x4 o; o.x = cvt_pk_bf16(kd[0], kd[1]); o.y = cvt_pk_bf16(kd[2], kd[3]); o.z = cvt_pk_bf16(kd[4], kd[5]); o.w = cvt_pk_bf16(kd[6], kd[7]);
        *(LAS u32x4*)(sKd + d * KDP + hf * 32 + i8 * 8) = o;
    }
    __syncthreads();
    {
        const int tt = w >> 1;
#pragma unroll
        for (int s2 = 0; s2 < 2; ++s2) {
            const int st = (w & 1) * 2 + s2;
            f32x4 a4 = {0.f, 0.f, 0.f, 0.f};
#pragma unroll
            for (int ks = 0; ks < 8; ++ks) {
                const bf16x8 ka = *(const LAS bf16x8*)(sK + (16 * st + l15) * QP + 32 * ks + 8 * quad);
                const bf16x8 qb = *(const LAS bf16x8*)(sQ + (16 * tt + l15) * QP + 32 * ks + 8 * quad);
                a4 = mfma16(ka, qb, a4);
            }
            const int t = 16 * tt + l15, s0 = 16 * st + 4 * quad;
#pragma unroll
            for (int j = 0; j < 4; ++j) if (s0 + j > t) a4[j] = 0.f;
            *(u32x2*)(attb + ((size_t)(ci * 4 + h) * 64 + t) * 64 + s0) = pack4(a4);
        }
    }
    __syncthreads();
#pragma unroll
    for (int i = 0; i < 8; ++i) {
        const int ch = tid + 512 * i, s = ch >> 6, c16 = ch & 63;
        *(LAS u32x4*)(sV + s * VPI + c16 * 8) = *(const u32x4*)(vg + (size_t)(r0 + s) * 2048 + h * 512 + c16 * 8);
    }
    __syncthreads();
    {
        const int q4 = (lane >> 2) & 3, p4 = lane & 3;
        bf16x8 vf[4][2];
#pragma unroll
        for (int vt = 0; vt < 4; ++vt)
#pragma unroll
            for (int ks = 0; ks < 2; ++ks) {
                const LAS bf16_t* a0 = sV + (32 * ks + 8 * quad + q4) * VPI + 64 * w + 16 * vt + 4 * p4;
                vf[vt][ks] = trread2(a0, a0 + 4 * VPI);
            }
        const bool prm = ci < 128;
        for (int dg = 0; dg < 4; ++dg) {
            f32x4 acc[4][4];
#pragma unroll
            for (int a = 0; a < 4; ++a)
#pragma unroll
                for (int b = 0; b < 4; ++b) acc[a][b] = (f32x4){0.f, 0.f, 0.f, 0.f};
#pragma unroll
            for (int dt = 0; dt < 4; ++dt)
#pragma unroll
                for (int ks = 0; ks < 2; ++ks) {
                    const bf16x8 kf = *(const LAS bf16x8*)(sKd + (64 * dg + 16 * dt + l15) * KDP + 32 * ks + 8 * quad);
#pragma unroll
                    for (int vt = 0; vt < 4; ++vt) acc[vt][dt] = prm ? mfma16(kf, vf[vt][ks], acc[vt][dt]) : mfma16(vf[vt][ks], kf, acc[vt][dt]);
                }
            if (prm) {
#pragma unroll
                for (int vt = 0; vt < 4; ++vt)
#pragma unroll
                    for (int dt = 0; dt < 4; ++dt)
                        *(u32x2*)(dsb + ((size_t)(ci * 4 + h) * 512 + 64 * w + 16 * vt + l15) * 256 + 64 * dg + 16 * dt + 4 * quad) = pack4(acc[vt][dt]);
            } else {
                const int b = ci - 128;
#pragma unroll
                for (int vt = 0; vt < 4; ++vt)
#pragma unroll
                    for (int dt = 0; dt < 4; ++dt) {
                        const int dd = 64 * dg + 16 * dt + l15, v = 64 * w + 16 * vt + 4 * quad;
                        const size_t off = ((size_t)(b * 4 + h) * 256 + dd) * 512 + v;
                        const f32x4 s0 = *(const f32x4*)(p.state_gla + off);
                        *(f32x4*)(p.out + O_SGS + off) = s0 * sDec[dd] + acc[vt][dt];
                    }
            }
        }
    }
    __syncthreads();
}

__device__ __forceinline__ void gla_c2(const Params& p) {
    bf16_t* dsb = (bf16_t*)(p.ws + WS_DS); const float* dec = (const float*)(p.ws + WS_DEC);
    for (int e = blockIdx.x * 512 + fresh_tid(); e < 131072; e += gridDim.x * 512) {
        const int h = e >> 15, rem = e & 32767, v = rem >> 6, d4 = (rem & 63) * 4;
        f32x4 s = {0.f, 0.f, 0.f, 0.f};
        for (int n0 = 0; n0 < 128; n0 += 8) {
            u32x2 x[8]; f32x4 dc[8];
#pragma unroll
            for (int i = 0; i < 8; ++i) {
                x[i] = *(const u32x2*)(dsb + ((size_t)((n0 + i) * 4 + h) * 512 + v) * 256 + d4);
                dc[i] = *(const f32x4*)(dec + (size_t)((n0 + i) * 4 + h) * 256 + d4);
            }
#pragma unroll
            for (int i = 0; i < 8; ++i) {
                *(u32x2*)(dsb + ((size_t)((n0 + i) * 4 + h) * 512 + v) * 256 + d4) = pack4(s);
                f32x4 dx; dx[0] = bf2f(x[i].x & 0xffffu); dx[1] = bf2f(x[i].x >> 16); dx[2] = bf2f(x[i].y & 0xffffu); dx[3] = bf2f(x[i].y >> 16);
                s = dc[i] * s + dx;
            }
        }
#pragma unroll
        for (int i = 0; i < 4; ++i) p.out[O_SGP + ((size_t)(h * 256 + d4 + i)) * 512 + v] = s[i];
    }
}

__device__ __forceinline__ void gla_c3(ldsp lds, const Params& p, int ci, int h) {
    const int tid = fresh_tid(), lane = tid & 63, w = tid >> 6, quad = lane >> 4, l15 = lane & 15;
    const int r0 = ci < 128 ? ci * 64 : TP + (ci - 128) * 64;
    LAS bf16_t* sQ = (LAS bf16_t*)lds;
    LAS bf16_t* sA = (LAS bf16_t*)(lds + 33792);
    LAS bf16_t* sV = (LAS bf16_t*)(lds + 43008);
    LAS float* sR = (LAS float*)(lds + 110592);
    const bf16_t* vg = (const bf16_t*)(p.ws + WS_VG); const bf16_t* gg = (const bf16_t*)(p.ws + WS_GG);
    const bf16_t* qt = (const bf16_t*)(p.ws + WS_QT); const bf16_t* attb = (const bf16_t*)(p.ws + WS_ATT); const bf16_t* dsb = (const bf16_t*)(p.ws + WS_DS);
    bf16_t* og = (bf16_t*)(p.ws + WS_OG);
#pragma unroll
    for (int i = 0; i < 4; ++i) {
        const int ch = tid + 512 * i, t = ch >> 5, c = ch & 31;
        *(LAS u32x4*)(sQ + t * QP + c * 8) = *(const u32x4*)(qt + (size_t)(r0 + t) * 1024 + h * 256 + c * 8);
    }
    { const int t = tid >> 3, c = tid & 7; *(LAS u32x4*)(sA + t * KDP + c * 8) = *(const u32x4*)(attb + ((size_t)(ci * 4 + h) * 64 + t) * 64 + c * 8); }
#pragma unroll
    for (int i = 0; i < 8; ++i) {
        const int ch = tid + 512 * i, s = ch >> 6, c16 = ch & 63;
        *(LAS u32x4*)(sV + s * VPI + c16 * 8) = *(const u32x4*)(vg + (size_t)(r0 + s) * 2048 + h * 512 + c16 * 8);
    }
    __syncthreads();
    f32x4 acc[4][4];
#pragma unroll
    for (int a = 0; a < 4; ++a)
#pragma unroll
        for (int b = 0; b < 4; ++b) acc[a][b] = (f32x4){0.f, 0.f, 0.f, 0.f};
    const int q4 = (lane >> 2) & 3, p4 = lane & 3;
#pragma unroll
    for (int ks = 0; ks < 2; ++ks) {
        bf16x8 af[4], vf[4];
#pragma unroll
        for (int tt = 0; tt < 4; ++tt) af[tt] = *(const LAS bf16x8*)(sA + (16 * tt + l15) * KDP + 32 * ks + 8 * quad);
#pragma unroll
        for (int vt = 0; vt < 4; ++vt) { const LAS bf16_t* a0 = sV + (32 * ks + 8 * quad + q4) * VPI + 64 * w + 16 * vt + 4 * p4; vf[vt] = trread2(a0, a0 + 4 * VPI); }
#pragma unroll
        for (int tt = 0; tt < 4; ++tt)
#pragma unroll
            for (int vt = 0; vt < 4; ++vt) acc[tt][vt] = mfma16(vf[vt], af[tt], acc[tt][vt]);
    }
    const bool prm = ci < 128;
    for (int ks = 0; ks < 8; ++ks) {
        bf16x8 qf[4], sf[4];
#pragma unroll
        for (int tt = 0; tt < 4; ++tt) qf[tt] = *(const LAS bf16x8*)(sQ + (16 * tt + l15) * QP + 32 * ks + 8 * quad);
        if (prm) {
#pragma unroll
            for (int vt = 0; vt < 4; ++vt) sf[vt] = *(const bf16x8*)(dsb + ((size_t)(ci * 4 + h) * 512 + 64 * w + 16 * vt + l15) * 256 + 32 * ks + 8 * quad);
        } else {
            const int b = ci - 128;
#pragma unroll
            for (int vt = 0; vt < 4; ++vt) {
                const float* sp = p.state_gla + ((size_t)(b * 4 + h) * 256 + 32 * ks + 8 * quad) * 512 + 64 * w + 16 * vt + l15;
                float f[8];
#pragma unroll
                for (int j = 0; j < 8; ++j) f[j] = sp[(size_t)j * 512];
                union { u32x4 u; bf16x8 v; } cv; cv.u.x = cvt_pk_bf16(f[0], f[1]); cv.u.y = cvt_pk_bf16(f[2], f[3]); cv.u.z = cvt_pk_bf16(f[4], f[5]); cv.u.w = cvt_pk_bf16(f[6], f[7]);
                sf[vt] = cv.v;
            }
        }
#pragma unroll
        for (int tt = 0; tt < 4; ++tt)
#pragma unroll
            for (int vt = 0; vt < 4; ++vt) acc[tt][vt] = mfma16(sf[vt], qf[tt], acc[tt][vt]);
    }
#pragma unroll
    for (int tt = 0; tt < 4; ++tt) {
        float ss = 0.f;
#pragma unroll
        for (int vt = 0; vt < 4; ++vt)
#pragma unroll
            for (int j = 0; j < 4; ++j) ss += acc[tt][vt][j] * acc[tt][vt][j];
        ss += __shfl_xor(ss, 16); ss += __shfl_xor(ss, 32);
        if (quad == 0) sR[(16 * tt + l15) * 8 + w] = ss;
    }
    __syncthreads();
#pragma unroll
    for (int tt = 0; tt < 4; ++tt) {
        const int t = 16 * tt + l15;
        const f32x4 x0 = *(const LAS f32x4*)(sR + t * 8), x1 = *(const LAS f32x4*)(sR + t * 8 + 4);
        const float rs = rsqrtf((x0[0] + x0[1] + x0[2] + x0[3] + x1[0] + x1[1] + x1[2] + x1[3]) * (1.f / 512.f) + EPS);
#pragma unroll
        for (int vt = 0; vt < 4; ++vt) {
            const int v = 64 * w + 16 * vt + 4 * quad;
            const u32x2 gr = *(const u32x2*)(gg + (size_t)(r0 + t) * 2048 + h * 512 + v);
            const f32x4 go = *(const f32x4*)(p.gla_g_out + v);
            f32x4 o;
            o[0] = acc[tt][vt][0] * rs * go[0] * silu(bf2f(gr.x & 0xffffu));
            o[1] = acc[tt][vt][1] * rs * go[1] * silu(bf2f(gr.x >> 16));
            o[2] = acc[tt][vt][2] * rs * go[2] * silu(bf2f(gr.y & 0xffffu));
            o[3] = acc[tt][vt][3] * rs * go[3] * silu(bf2f(gr.y >> 16));
            *(u32x2*)(og + (size_t)(r0 + t) * 2048 + h * 512 + v) = pack4(o);
        }
    }
    __syncthreads();
}

__device__ __forceinline__ void cum_phase(const Params& p) {
    const int tid = fresh_tid(), lane = tid & 63, w = tid >> 6;
    float* nbp = (float*)(p.ws + WS_NBP); float* nbs = (float*)(p.ws + WS_NBS);
    for (int s = w * gridDim.x + blockIdx.x; s < 144; s += 8 * gridDim.x) {
        const bool prm = s < 16;
        const int nch = prm ? 128 : 33;
        const int b = (s - 16) >> 4, hh = prm ? s : ((s - 16) & 15);
        float* dst = prm ? nbp + (size_t)hh * 8192 : nbs + (size_t)(b * 16 + hh) * 2112;
        float carry = 0.f;
        for (int c = 0; c < nch; c += 4) {
            float v[4];
#pragma unroll
            for (int i = 0; i < 4; ++i) {
                const int pos = (c + i) * 64 + lane;
                v[i] = 0.f;
                if (c + i < nch)
                    v[i] = prm ? p.out[O_LFP + (size_t)pos * 16 + hh]
                               : (pos < 2048 ? p.cache_logf[((size_t)b * 2048 + pos) * 16 + hh] : p.out[O_LFS + ((size_t)b * 64 + pos - 2048) * 16 + hh]);
            }
#pragma unroll
            for (int i = 0; i < 4; ++i) {
                if (c + i < nch) {
                    float inc = v[i];
#pragma unroll
                    for (int o = 1; o < 64; o <<= 1) { const float t = __shfl_up(inc, o); if (lane >= o) inc += t; }
                    dst[(c + i) * 64 + lane] = -(carry + inc) * LOG2E;
                    carry += __shfl(inc, 63);
                }
            }
        }
    }
    bf16_t* ksb = (bf16_t*)(p.ws + WS_KSB); bf16_t* vsb = (bf16_t*)(p.ws + WS_VSB);
    for (size_t c = (size_t)blockIdx.x * 512 + tid; c < (size_t)8 * 2048 * 256; c += (size_t)gridDim.x * 512) {
        const size_t rowi = c >> 8, cc = (c & 255) * 8;
        const size_t bb = rowi >> 11, pos = rowi & 2047;
        const float* ks = p.cache_k + rowi * 2048 + cc; const float* vs = p.cache_v + rowi * 2048 + cc;
        const f32x4 k0 = *(const f32x4*)ks, k1 = *(const f32x4*)(ks + 4), v0 = *(const f32x4*)vs, v1 = *(const f32x4*)(vs + 4);
        *(u32x4*)(ksb + (bb * 2112 + pos) * 2048 + cc) = pack8(k0, k1);
        *(u32x4*)(vsb + (bb * 2112 + pos) * 2048 + cc) = pack8(v0, v1);
    }
}

constexpr int AKP = 136, AVP = 144;
template <int QT, int NH>
__device__ __forceinline__ void attn_item(ldsp lds, const bf16_t* qo, bf16_t* ao, int qrow_wave, int qpos_wave, int hcol_wave, int hsel,
                                          const bf16_t* kbase, const bf16_t* vbase, const float* nb0, const float* nb1, int ntiles) {
    const int tid = fresh_tid(), lane = tid & 63, quad = lane >> 4, l15 = lane & 15;
    constexpr int STG = NH * (64 * AKP * 2 + 64 * AVP * 2 + 256);
    constexpr int KOFF = 0, VOFF = NH * 64 * AKP * 2, NOFF = VOFF + NH * 64 * AVP * 2;
    constexpr int NC = 2 * NH;
    bf16x8 qf[QT][4];
#pragma unroll
    for (int qt = 0; qt < QT; ++qt)
#pragma unroll
        for (int ks = 0; ks < 4; ++ks) qf[qt][ks] = *(const bf16x8*)(qo + (size_t)(qrow_wave + 16 * qt + l15) * DM + hcol_wave + 32 * ks + 8 * quad);
    f32x4 O[QT][8];
#pragma unroll
    for (int qt = 0; qt < QT; ++qt)
#pragma unroll
        for (int dt = 0; dt < 8; ++dt) O[qt][dt] = (f32x4){0.f, 0.f, 0.f, 0.f};
    float mrow[QT], lsum[QT];
#pragma unroll
    for (int qt = 0; qt < QT; ++qt) { mrow[qt] = -1e30f; lsum[qt] = 0.f; }
    u32x4 kreg[NC], vreg[NC]; float nreg = 0.f;
    const int q4 = (lane >> 2) & 3, p4 = lane & 3;
    const int qmax = qpos_wave + 16 * QT - 1;
#define ATT_LOAD(it) do { _Pragma("unroll") for (int i = 0; i < NC; ++i) { const int ch = tid + 512 * i, key = ch / (16 * NH), c = ch % (16 * NH); \
            kreg[i] = *(const u32x4*)(kbase + (size_t)((it) * 64 + key) * DM + c * 8); vreg[i] = *(const u32x4*)(vbase + (size_t)((it) * 64 + key) * DM + c * 8); } \
        if (tid < 64 * NH) nreg = (tid < 64 ? nb0 : nb1)[(it) * 64 + (tid & 63)]; } while (0)
#define ATT_STORE(st) do { ldsp sb = lds + (st) * STG; _Pragma("unroll") for (int i = 0; i < NC; ++i) { const int ch = tid + 512 * i, key = ch / (16 * NH), c = ch % (16 * NH), hh = c >> 4, cc = c & 15; \
            *(LAS u32x4*)(sb + KOFF + ((hh * 64 + key) * AKP + cc * 8) * 2) = kreg[i]; *(LAS u32x4*)(sb + VOFF + ((hh * 64 + key) * AVP + cc * 8) * 2) = vreg[i]; } \
        if (tid < 64 * NH) *(LAS float*)(sb + NOFF + tid * 4) = nreg; } while (0)
    ATT_LOAD(0);
    ATT_STORE(0);
    __syncthreads();
    for (int it = 0; it < ntiles; ++it) {
        const bool more = it + 1 < ntiles;
        if (more) ATT_LOAD(it + 1);
        const int key0 = it * 64;
        if (key0 <= qmax) {
            ldsp sb = lds + (it & 1) * STG;
            const LAS bf16_t* sK = (const LAS bf16_t*)(sb + KOFF) + hsel * 64 * AKP;
            const LAS bf16_t* sV = (const LAS bf16_t*)(sb + VOFF) + hsel * 64 * AVP;
            const LAS float* sN = (const LAS float*)(sb + NOFF) + hsel * 64;
            f32x4 S[QT][4];
#pragma unroll
            for (int qt = 0; qt < QT; ++qt)
#pragma unroll
                for (int kg = 0; kg < 4; ++kg) S[qt][kg] = (f32x4){0.f, 0.f, 0.f, 0.f};
#pragma unroll
            for (int ks = 0; ks < 4; ++ks)
#pragma unroll
                for (int kg = 0; kg < 4; ++kg) {
                    const bf16x8 kf = *(const LAS bf16x8*)(sK + (16 * kg + l15) * AKP + 32 * ks + 8 * quad);
#pragma unroll
                    for (int qt = 0; qt < QT; ++qt) S[qt][kg] = mfma16(kf, qf[qt][ks], S[qt][kg]);
                    if (kg == 3) __builtin_amdgcn_sched_barrier(0);
                }
            f32x4 nbv[4];
#pragma unroll
            for (int kg = 0; kg < 4; ++kg) nbv[kg] = *(const LAS f32x4*)(sN + 16 * kg + 4 * quad);
            const bool need_mask = key0 + 63 > qpos_wave;
            bf16x8 pf[QT][2];
#pragma unroll
            for (int qt = 0; qt < QT; ++qt) {
                const int qpos = qpos_wave + 16 * qt + l15;
#pragma unroll
                for (int kg = 0; kg < 4; ++kg) {
                    S[qt][kg] += nbv[kg];
                    if (need_mask) {
#pragma unroll
                        for (int j = 0; j < 4; ++j) if (key0 + 16 * kg + 4 * quad + j > qpos) S[qt][kg][j] = -INFINITY;
                    }
                }
                float mx = -INFINITY;
#pragma unroll
                for (int kg = 0; kg < 4; ++kg)
#pragma unroll
                    for (int j = 0; j < 4; ++j) mx = fmaxf(mx, S[qt][kg][j]);
                mx = fmaxf(mx, __shfl_xor(mx, 16)); mx = fmaxf(mx, __shfl_xor(mx, 32));
                const float mnew = fmaxf(mrow[qt], mx);
                const float alpha = exp2f(mrow[qt] - mnew);
                mrow[qt] = mnew;
                float ps = 0.f;
#pragma unroll
                for (int kg = 0; kg < 4; ++kg)
#pragma unroll
                    for (int j = 0; j < 4; ++j) { const float pv = exp2f(S[qt][kg][j] - mnew); S[qt][kg][j] = pv; ps += pv; }
                lsum[qt] = lsum[qt] * alpha + ps;
#pragma unroll
                for (int dt = 0; dt < 8; ++dt) O[qt][dt] *= alpha;
#pragma unroll
                for (int i = 0; i < 2; ++i) { union { u32x4 u; bf16x8 v; } cv; cv.u = pack8(S[qt][2 * i], S[qt][2 * i + 1]); pf[qt][i] = cv.v; }
                __builtin_amdgcn_sched_barrier(0);
            }
#pragma unroll
            for (int i = 0; i < 2; ++i)
#pragma unroll
                for (int dt = 0; dt < 8; ++dt) {
                    const LAS bf16_t* a0 = sV + (32 * i + 4 * quad + q4) * AVP + 16 * dt + 4 * p4;
                    const bf16x8 vf = trread2(a0, a0 + 16 * AVP);
#pragma unroll
                    for (int qt = 0; qt < QT; ++qt) O[qt][dt] = mfma16(vf, pf[qt][i], O[qt][dt]);
                    if ((dt & 3) == 3) __builtin_amdgcn_sched_barrier(0);
                }
        }
        if (more) ATT_STORE((it + 1) & 1);
        __syncthreads();
    }
#undef ATT_LOAD
#undef ATT_STORE
#pragma unroll
    for (int qt = 0; qt < QT; ++qt) {
        float l = lsum[qt]; l += __shfl_xor(l, 16); l += __shfl_xor(l, 32);
        const float inv = 1.f / l;
#pragma unroll
        for (int dt = 0; dt < 8; ++dt)
            *(u32x2*)(ao + (size_t)(qrow_wave + 16 * qt + l15) * DM + hcol_wave + 16 * dt + 4 * quad) = pack4(O[qt][dt] * inv);
    }
}

__device__ __forceinline__ void attn_phase(ldsp lds, const Params& p) {
    const int w = fresh_tid() >> 6;
    const bf16_t* qo = (const bf16_t*)(p.ws + WS_QB); bf16_t* ao = (bf16_t*)(p.ws + WS_AO);
    const bf16_t* kpb = (const bf16_t*)(p.ws + WS_KPB); const bf16_t* vpb = (const bf16_t*)(p.ws + WS_VPB);
    const bf16_t* ksb = (const bf16_t*)(p.ws + WS_KSB); const bf16_t* vsb = (const bf16_t*)(p.ws + WS_VSB);
    const float* nbp = (const float*)(p.ws + WS_NBP); const float* nbs = (const float*)(p.ws + WS_NBS);
    for (int pi = blockIdx.x; pi < 256; pi += gridDim.x) {
        const int h = pi >> 4, pr = pi & 15;
        for (int half = 0; half < 2; ++half) {
            const int qb = half ? pr : 31 - pr;
            attn_item<2, 1>(lds, qo, ao, qb * 256 + 32 * w, qb * 256 + 32 * w, h * 128, 0, kpb + h * 128, vpb + h * 128, nbp + (size_t)h * 8192, nbp + (size_t)h * 8192, 4 * (qb + 1));
        }
    }
    for (int si = blockIdx.x; si < 64; si += gridDim.x) {
        const int b = si >> 3, hp = si & 7;
        const int head = 2 * hp + (w >> 2);
        attn_item<1, 2>(lds, qo, ao, TP + b * 64 + 16 * (w & 3), 2048 + 16 * (w & 3), head * 128, w >> 2,
                        ksb + (size_t)b * 2112 * DM + hp * 256, vsb + (size_t)b * 2112 * DM + hp * 256,
                        nbs + (size_t)(b * 16 + 2 * hp) * 2112, nbs + (size_t)(b * 16 + 2 * hp + 1) * 2112, 33);
    }
}

template <class Epi> __device__ __forceinline__ void run_gemm(ldsp lds, const bf16_t* A, const bf16_t* Bt, int N, int K, const Epi& E) {
    pg8::Gemm g; g.A = A; g.Bt = Bt; g.M = T; g.N = N; g.K = K;
    pg8::StaticOrder S; S.init(T, N, (int)gridDim.x, (int)blockIdx.x);
    pg8::gemm_phase<Epi, pg8::StaticOrder, false>(lds, g, S, E, nullptr);
}

__global__ void __launch_bounds__(512) fwd_megakernel(Params p) {
    extern __shared__ __attribute__((aligned(16))) unsigned char smem[];
    ldsp lds = (ldsp)smem;
    cg::grid_group grid = cg::this_grid();
    unsigned char* ws = p.ws;
    float* ssq = (float*)(ws + WS_SSQ);
    bf16_t* hb = (bf16_t*)(ws + WS_HB);
#ifndef NO_P0
    prep_phase(lds, p);
#endif
    grid.sync();
#ifndef NO_P1
    { Epi1 E; E.ssq = ssq; E.qg = (bf16_t*)(ws + WS_QG); E.kg = (bf16_t*)(ws + WS_KG); E.vg = (bf16_t*)(ws + WS_VG); E.gg = (bf16_t*)(ws + WS_GG); E.gkl = (float*)(ws + WS_GKL);
      run_gemm(lds, hb, (const bf16_t*)(ws + WS_W1), 6400, 2048, E); }
#endif
    grid.sync();
#ifndef NO_P2
    for (int it = blockIdx.x; it < 544; it += gridDim.x) gla_c1(lds, p, it >> 2, it & 3);
#endif
    grid.sync();
#ifndef NO_P3
    gla_c2(p);
#endif
    grid.sync();
#ifndef NO_P4
    for (int it = blockIdx.x; it < 544; it += gridDim.x) gla_c3(lds, p, it >> 2, it & 3);
#endif
    grid.sync();
#ifndef NO_RES
    { EpiRes<false> E; E.res_p = p.x_prompt; E.res_s = p.x_sample; E.y = p.out + O_Y; E.hb = hb; E.ssq_out = ssq + T;
      run_gemm(lds, (const bf16_t*)(ws + WS_OG), (const bf16_t*)(ws + WS_W2), 2048, 2048, E); }
#endif
    grid.sync();
#ifndef NO_GLU
    { EpiGlu E; E.ssq = ssq + T; E.mid = (bf16_t*)(ws + WS_MID); run_gemm(lds, hb, (const bf16_t*)(ws + WS_W3), 11264, 2048, E); }
#endif
    grid.sync();
    { EpiRes<false> E; E.res_p = p.out + O_Y; E.res_s = p.out + O_Y + (size_t)TP * DM; E.y = p.out + O_Y; E.hb = hb; E.ssq_out = ssq + 2 * T;
      run_gemm(lds, (const bf16_t*)(ws + WS_MID), (const bf16_t*)(ws + WS_W4), 2048, 5632, E); }
    grid.sync();
#ifndef NO_KVQ
    { EpiKvq E; E.ssq = ssq + 2 * T; E.out = p.out; E.qb = (bf16_t*)(ws + WS_QB); E.kpb = (bf16_t*)(ws + WS_KPB); E.vpb = (bf16_t*)(ws + WS_VPB);
      E.ksb = (bf16_t*)(ws + WS_KSB); E.vsb = (bf16_t*)(ws + WS_VSB); E.g_k = p.kv_g_k; E.g_q = p.fox_g_q; E.b_f = p.kv_b_f; E.lds = lds;
      run_gemm(lds, hb, (const bf16_t*)(ws + WS_W5), 6400, 2048, E); }
#endif
    grid.sync();
#ifndef NO_P9
    cum_phase(p);
#endif
    grid.sync();
#ifndef NO_ATT
    attn_phase(lds, p);
#ifdef PROBE_ATT2
    attn_phase(lds, p);
#endif
#endif
    grid.sync();
    { EpiRes<false> E; E.res_p = p.out + O_Y; E.res_s = p.out + O_Y + (size_t)TP * DM; E.y = p.out + O_Y; E.hb = hb; E.ssq_out = ssq + 3 * T;
      run_gemm(lds, (const bf16_t*)(ws + WS_AO), (const bf16_t*)(ws + WS_W6), 2048, 2048, E); }
    grid.sync();
    { EpiGlu E; E.ssq = ssq + 3 * T; E.mid = (bf16_t*)(ws + WS_MID); run_gemm(lds, hb, (const bf16_t*)(ws + WS_W3) + (size_t)11264 * 2048, 11264, 2048, E); }
    grid.sync();
    { EpiRes<true> E; E.res_p = p.out + O_Y; E.res_s = p.out + O_Y + (size_t)TP * DM; E.y = p.out + O_Y; E.hb = hb; E.ssq_out = ssq;
      run_gemm(lds, (const bf16_t*)(ws + WS_MID), (const bf16_t*)(ws + WS_W4) + (size_t)2048 * 5632, 2048, 5632, E); }
}

extern "C" void kernel_launch(void* const* d_in, const int* in_sizes, int n_in, void* d_out, int out_size, void* d_ws, size_t ws_size, hipStream_t stream) {
    static int grid_blocks = 0;
    if (grid_blocks == 0) {
        if (n_in != 22 || ws_size < WS_END) { fprintf(stderr, "kernel_launch: need 22 inputs and %zu bytes of workspace; got %d, %zu\n", (size_t)WS_END, n_in, ws_size); grid_blocks = -1; return; }
        int dev = 0, cus = 0, per_cu = 0;
        hipGetDevice(&dev);
        hipDeviceGetAttribute(&cus, hipDeviceAttributeMultiprocessorCount, dev);
        hipFuncSetAttribute((const void*)fwd_megakernel, hipFuncAttributeMaxDynamicSharedMemorySize, LDS_BYTES);
        hipOccupancyMaxActiveBlocksPerMultiprocessor(&per_cu, (const void*)fwd_megakernel, 512, LDS_BYTES);
        (void)hipGetLastError();
        if (per_cu < 1) per_cu = 1;
        if (per_cu > 1) per_cu = 1;
        grid_blocks = cus * per_cu;
    }
    if (grid_blocks < 0) return;
    Params p{};
    const float** pp = (const float**)&p;
    for (int i = 0; i < 22; ++i) pp[i] = (const float*)d_in[i];
    p.out = (float*)d_out; p.ws = (unsigned char*)d_ws;
    void* args[] = {&p};
    hipError_t e = hipLaunchCooperativeKernel((const void*)fwd_megakernel, dim3(grid_blocks), dim3(512), args, LDS_BYTES, stream);
    if (e != hipSuccess) fprintf(stderr, "cooperative launch failed: %s (grid %d)\n", hipGetErrorString(e), grid_blocks);
}
```
